# Optimizing an MI355X kernel written in HIP

```python
import jax, jax.numpy as jnp
from jax import lax
import numpy as np

D_MODEL = 1024
BATCH = 4
SEQ = 4096
DEPTH = 1

HEAD_DIM = 64
W_CONV = D_MODEL // 2
W_ATTN = D_MODEL - W_CONV
N_CONV_GROUPS = W_CONV // HEAD_DIM
N_ATTN_HEADS = W_ATTN // HEAD_DIM
CONV_K = 3
D_FF = 4 * D_MODEL
PLE_DIM = 256
Q_BLOCK = 128
EPS = 1e-6
IN_COLS = 3 * W_CONV + 3 * W_ATTN

kernel_name = "hymba_shortconv_stickbreaking_hybrid"


def rmsnorm(x, g):
    xf = x.astype(jnp.float32)
    y = xf * lax.rsqrt(jnp.mean(xf * xf, axis=-1, keepdims=True) + EPS)
    return (y * g.astype(jnp.float32)).astype(x.dtype)


def head_rmsnorm(y, g):
    b, s, w = y.shape
    yf = y.astype(jnp.float32).reshape(b, s, w // HEAD_DIM, HEAD_DIM)
    yf = yf * lax.rsqrt(jnp.mean(yf * yf, axis=-1, keepdims=True) + EPS)
    return (yf.reshape(b, s, w) * g.astype(jnp.float32)).astype(y.dtype)


def short_gated_conv(b_gate, c_gate, u, w_conv):
    v = c_gate * u
    y = lax.conv_general_dilated(
        v, w_conv[:, None, :].astype(v.dtype),
        window_strides=(1,), padding=[(CONV_K - 1, 0)],
        dimension_numbers=('NWC', 'WIO', 'NWC'),
        feature_group_count=v.shape[-1])
    return b_gate * y


def stick_breaking_attention(q, k, v):
    b, h, s, dh = q.shape
    n_blk = s // Q_BLOCK
    scale = dh ** -0.5
    qb = q.reshape(b, h, n_blk, Q_BLOCK, dh).transpose(2, 0, 1, 3, 4)
    kf = k.astype(jnp.float32)
    vf = v.astype(jnp.float32)
    key_pos = jnp.arange(s)

    def one_block(args):
        qi, blk = args
        z = jnp.einsum('bhqd,bhkd->bhqk', qi.astype(jnp.float32), kf) * scale
        q_pos = blk * Q_BLOCK + jnp.arange(Q_BLOCK)
        mask = key_pos[None, :] < q_pos[:, None]
        log_keep = jnp.where(mask, jax.nn.log_sigmoid(-z), 0.0)
        suffix = lax.cumsum(log_keep, axis=3, reverse=True) - log_keep
        a = jnp.where(mask, jnp.exp(jax.nn.log_sigmoid(z) + suffix), 0.0)
        return jnp.einsum('bhqk,bhkd->bhqd', a, vf)

    out = lax.map(one_block, (qb, jnp.arange(n_blk)))
    return out.transpose(1, 2, 0, 3, 4).reshape(b, h, s, dh).astype(q.dtype)


def setup_inputs(seed: int = 0) -> dict:
    key = jax.random.key(seed)
    ks = jax.random.split(key, 20)
    f32 = jnp.float32

    def nrm(k, shape, fan_in):
        return jax.random.normal(k, shape, f32) * (fan_in ** -0.5)

    def gain(k, shape):
        return 1.0 + 0.02 * jax.random.normal(k, shape, f32)

    return {
        "x": jax.random.normal(ks[0], (BATCH, SEQ, D_MODEL), f32),
        "p": jax.random.normal(ks[1], (DEPTH, BATCH, SEQ, PLE_DIM), f32),
        "g_mix": gain(ks[2], (DEPTH, D_MODEL)),
        "w_in": nrm(ks[3], (DEPTH, D_MODEL, IN_COLS), D_MODEL),
        "conv_w": nrm(ks[4], (DEPTH, CONV_K, W_CONV), CONV_K),
        "g_conv_out": gain(ks[5], (DEPTH, W_CONV)),
        "g_attn_out": gain(ks[6], (DEPTH, W_ATTN)),
        "w_out": nrm(ks[7], (DEPTH, W_CONV + W_ATTN, D_MODEL), W_CONV + W_ATTN),
        "g_mlp": gain(ks[8], (DEPTH, D_MODEL)),
        "w_up": nrm(ks[9], (DEPTH, D_MODEL, D_FF), D_MODEL),
        "w_down": nrm(ks[10], (DEPTH, D_FF, D_MODEL), D_FF),
        "g_ple": gain(ks[11], (DEPTH, D_MODEL)),
        "w_ple_gate": nrm(ks[12], (DEPTH, D_MODEL, D_MODEL), D_MODEL),
        "w_ple_proj": nrm(ks[13], (DEPTH, PLE_DIM, D_MODEL), PLE_DIM),
        "g_final": gain(ks[14], (D_MODEL,)),
    }


def reference(x, p, g_mix, w_in, conv_w, g_conv_out, g_attn_out, w_out, g_mlp, w_up, w_down,
              g_ple, w_ple_gate, w_ple_proj, g_final):
    b, s, _ = x.shape
    splits = [W_CONV, 2 * W_CONV, 3 * W_CONV, 3 * W_CONV + W_ATTN, 3 * W_CONV + 2 * W_ATTN]
    h = x
    for i in range(DEPTH):
        a = rmsnorm(h, g_mix[i])
        proj = a @ w_in[i]
        cb, cc, cu, q, k, v = jnp.split(proj, splits, axis=-1)
        conv_out = head_rmsnorm(short_gated_conv(cb, cc, cu, conv_w[i]), g_conv_out[i])
        to_heads = lambda t: t.reshape(b, s, N_ATTN_HEADS, HEAD_DIM).transpose(0, 2, 1, 3)
        attn = stick_breaking_attention(to_heads(q), to_heads(k), to_heads(v))
        attn = head_rmsnorm(attn.transpose(0, 2, 1, 3).reshape(b, s, W_ATTN), g_attn_out[i])
        h = h + jnp.concatenate([conv_out, attn], axis=-1) @ w_out[i]
        m = rmsnorm(h, g_mlp[i])
        h = h + jnp.square(jax.nn.relu(m @ w_up[i])) @ w_down[i]
        gate = jax.nn.sigmoid(rmsnorm(h, g_ple[i]) @ w_ple_gate[i])
        h = h + gate * (p[i] @ w_ple_proj[i])
    return rmsnorm(h, g_final)
```

```cpp
#include <hip/hip_runtime.h>
#include <hip/hip_cooperative_groups.h>
#include <cstdio>
#include <cstdint>
namespace pg8 {
#define PG8_LAS __attribute__((address_space(3)))
typedef unsigned short bf16_t;
typedef short bf16x8 __attribute__((ext_vector_type(8)));
typedef float f32x4 __attribute__((ext_vector_type(4)));
typedef unsigned u32x4 __attribute__((ext_vector_type(4)));
constexpr int BM = 256, BK = 64, HALF = 128, HTB = HALF * BK * 2  , STAGE_BYTES = 8 * HTB, NXCD = 8, WGM = 8;

__host__ __device__ __forceinline__ int lds_byte(int r, int c) { const int st = (r >> 4) * 2 + (c >> 5), rr = r & 15, cc = c & 31, ob = rr * 64 + cc * 2; return st * 1024 + (ob ^ (((ob >> 9) & 1) << 5)); }
__host__ __device__ __forceinline__ void stage_rc(int b, int& R, int& C) { const int st = b / 1024, sb = b % 1024, swz = sb ^ (((sb >> 9) & 1) << 5); R = (st >> 1) * 16 + swz / 64; C = (st & 1) * 32 + (swz % 64) / 2; }
__host__ __device__ __forceinline__ int perm32(int rho) { const int n = rho >> 4, i = rho & 15; return 8 * (i >> 2) + 4 * n + (i & 3); }

struct Unit { int pm, pn; };
struct Gemm { const bf16_t* A; const bf16_t* Bt; int M, N, K; };

struct StaticOrder {
    int nM, nN, nwg, G, c;
    __host__ __device__ void init(int M, int N, int G_, int c_) { nM = M / BM; nN = N / BM; nwg = nM * nN; G = G_; c = c_; }
    __host__ __device__ bool next(int i, Unit& u) const {
        const long L = (long)i * G + c; if (L >= nwg) return false;
        int wgid = (int)L; { const int q = nwg / NXCD, r = nwg % NXCD, xcd = wgid % NXCD, off = wgid / NXCD; wgid = (xcd < r ? xcd * (q + 1) : r * (q + 1) + (xcd - r) * q) + off; }
        const int nig = WGM * nN, gid = wgid / nig, fm = gid * WGM, gsz = (nM - fm) < WGM ? (nM - fm) : WGM;
        u.pm = fm + ((wgid % nig) % gsz); u.pn = (wgid % nig) / gsz; return true;
    }
    __device__ __forceinline__ void a_ready(const Unit&) const {}
    __device__ __forceinline__ void done(const Unit&) const {}
};

__device__ __forceinline__ unsigned cvt_pk_bf16(float lo, float hi) { unsigned r; asm volatile("v_cvt_pk_bf16_f32 %0, %1, %2" : "=v"(r) : "v"(lo), "v"(hi)); return r; }
typedef float f32x2 __attribute__((ext_vector_type(2)));
typedef unsigned u32x2 __attribute__((ext_vector_type(2)));
constexpr int NSS = 16;
__device__ __forceinline__ float row_rs(const float* ss, int M, int row, float eps) {
    float s = 0.f;
#pragma unroll
    for (int t = 0; t < NSS; ++t) s += ss[(size_t)t * M + row];
    return 1.0f / sqrtf(s * (1.0f / 1024.0f) + eps);
}
struct EpiBf16 {
    static constexpr bool PERM = true, AFTER_DRAIN = false;
    bf16_t* O; int ldc;
    __device__ __forceinline__ void operator()(const f32x4 (&acc)[2][2][4][2], const Unit& u, int wr, int wc, int fr, int fq) const {
        const int row0 = u.pm * BM + wr * 64 + fr, col0 = u.pn * BM + wc * 32 + 8 * fq;
#pragma unroll
        for (int ai = 0; ai < 2; ++ai)
#pragma unroll
            for (int m = 0; m < 4; ++m) { bf16_t* rowp = O + (size_t)(row0 + ai * HALF + m * 16) * ldc + col0;
#pragma unroll
                for (int bj = 0; bj < 2; ++bj) { const f32x4 v0 = acc[ai][bj][m][0], v1 = acc[ai][bj][m][1];
                    u32x4 w; w.x = cvt_pk_bf16(v0[0], v0[1]); w.y = cvt_pk_bf16(v0[2], v0[3]); w.z = cvt_pk_bf16(v1[0], v1[1]); w.w = cvt_pk_bf16(v1[2], v1[3]);
                    *(u32x4*)(rowp + bj * HALF) = w; } }
    }
};
struct EpiUp {
    static constexpr bool PERM = true, AFTER_DRAIN = false;
    bf16_t* O; int ldc; const float* ss; int M; float eps;
    __device__ __forceinline__ void operator()(const f32x4 (&acc)[2][2][4][2], const Unit& u, int wr, int wc, int fr, int fq) const {
        const int row0 = u.pm * BM + wr * 64 + fr, col0 = u.pn * BM + wc * 32 + 8 * fq;
#pragma unroll
        for (int ai = 0; ai < 2; ++ai)
#pragma unroll
            for (int m = 0; m < 4; ++m) { const int row = row0 + ai * HALF + m * 16; const float rs = row_rs(ss, M, row, eps); bf16_t* rowp = O + (size_t)row * ldc + col0;
#pragma unroll
                for (int bj = 0; bj < 2; ++bj) { f32x4 v0 = acc[ai][bj][m][0] * rs, v1 = acc[ai][bj][m][1] * rs;
#pragma unroll
                    for (int e = 0; e < 4; ++e) { const float a = fmaxf(v0[e], 0.f), b = fmaxf(v1[e], 0.f); v0[e] = a * a; v1[e] = b * b; }
                    u32x4 w; w.x = cvt_pk_bf16(v0[0], v0[1]); w.y = cvt_pk_bf16(v0[2], v0[3]); w.z = cvt_pk_bf16(v1[0], v1[1]); w.w = cvt_pk_bf16(v1[2], v1[3]);
                    *(u32x4*)(rowp + bj * HALF) = w; }
                asm volatile("" ::: "memory"); }
    }
};
struct EpiRes {
    static constexpr bool PERM = false, AFTER_DRAIN = false;
    const float* base; float* out; bf16_t* outb; int ldc; float* ss; int M;
    __device__ __forceinline__ void operator()(const f32x4 (&acc)[2][2][4][2], const Unit& u, int wr, int wc, int fr, int fq) const {
        const int col0 = u.pn * BM + wc * 32 + 4 * fq;
#pragma unroll
        for (int ai = 0; ai < 2; ++ai)
#pragma unroll
            for (int m = 0; m < 4; ++m) { const int row = u.pm * BM + ai * HALF + wr * 64 + m * 16 + fr; const size_t off = (size_t)row * ldc + col0; float q = 0.f;
#pragma unroll
                for (int bj = 0; bj < 2; ++bj)
#pragma unroll
                    for (int n = 0; n < 2; ++n) { const f32x4 bs = *(const f32x4*)(base + off + bj * HALF + n * 16); const f32x4 o = bs + acc[ai][bj][m][n];
                        *(f32x4*)(out + off + bj * HALF + n * 16) = o; u32x2 w; w.x = cvt_pk_bf16(o[0], o[1]); w.y = cvt_pk_bf16(o[2], o[3]); *(u32x2*)(outb + off + bj * HALF + n * 16) = w;
                        q += (o[0] * o[0] + o[1] * o[1]) + (o[2] * o[2] + o[3] * o[3]); }
                q += __shfl_xor(q, 16); q += __shfl_xor(q, 32);
                if (fq == 0) ss[(size_t)(u.pn * 4 + wc) * M + row] = q;
                asm volatile("" ::: "memory"); }
    }
};
struct EpiGate {
    static constexpr bool PERM = false, AFTER_DRAIN = false;
    const float* base; float* out; const bf16_t* pp; int ldc; const float* ss; int M; float eps;
    __device__ __forceinline__ void operator()(const f32x4 (&acc)[2][2][4][2], const Unit& u, int wr, int wc, int fr, int fq) const {
        const int col0 = u.pn * BM + wc * 32 + 4 * fq;
#pragma unroll
        for (int ai = 0; ai < 2; ++ai)
#pragma unroll
            for (int m = 0; m < 4; ++m) { const int row = u.pm * BM + ai * HALF + wr * 64 + m * 16 + fr; const size_t off = (size_t)row * ldc + col0; const float rs = row_rs(ss, M, row, eps);
#pragma unroll
                for (int bj = 0; bj < 2; ++bj)
#pragma unroll
                    for (int n = 0; n < 2; ++n) { const f32x4 bs = *(const f32x4*)(base + off + bj * HALF + n * 16); const u32x2 pw = *(const u32x2*)(pp + off + bj * HALF + n * 16);
                        const f32x4 a = acc[ai][bj][m][n] * rs;
                        f32x4 pv; pv[0] = __uint_as_float(pw.x << 16); pv[1] = __uint_as_float(pw.x & 0xffff0000u); pv[2] = __uint_as_float(pw.y << 16); pv[3] = __uint_as_float(pw.y & 0xffff0000u);
                        f32x4 o;
#pragma unroll
                        for (int e = 0; e < 4; ++e) { const float sg = __builtin_amdgcn_rcpf(1.0f + __expf(-a[e])); o[e] = bs[e] + sg * pv[e]; }
                        *(f32x4*)(out + off + bj * HALF + n * 16) = o; }
                asm volatile("" ::: "memory"); }
    }
};

template <class Epi, class Sched, bool ALIGN_EPI = false, bool SP2 = false>
__device__ __forceinline__ void gemm_phase(PG8_LAS unsigned char* lds, const Gemm g, const Sched& S, const Epi& E) {
    const int tid = threadIdx.x, wid = __builtin_amdgcn_readfirstlane(tid >> 6), lane = tid & 63, wr = wid >> 2, wc = wid & 3, fr = lane & 15, fq = lane >> 4;
    const int K = g.K, nt = K / BK;
    unsigned voffA[2], voffB[2];
#pragma unroll
    for (int i = 0; i < 2; ++i) { int R, C; stage_rc(tid * 16 + i * 8192, R, C); const int Rb = Epi::PERM ? ((R & ~31) + perm32(R & 31)) : R;
        voffA[i] = (unsigned)(R * K + C) * 2u; voffB[i] = (unsigned)(Rb * K + C) * 2u; }
    const size_t kstep = (size_t)(BK * 2);
    const size_t hstep = (size_t)HALF * K * 2;
    const size_t tstep = 2 * hstep;
    const unsigned ldsw = (unsigned)wid * 1024u;
    const int aoff = lds_byte(wr * 64 + fr, fq * 8), boff = lds_byte(wc * 32 + fr, fq * 8);
#define PG8_SA(b, h) (((b) * 2 + (h)) * HTB)
#define PG8_SB(b, h) ((4 + (b) * 2 + (h)) * HTB)
#define PG8_STAGE(bufoff, gbase, voff) do { _Pragma("unroll") for (int _i = 0; _i < 2; ++_i) \
        __builtin_amdgcn_global_load_lds((const unsigned*)((const char*)(gbase) + (voff)[_i]), (PG8_LAS unsigned*)(lds + (bufoff) + ldsw + _i * 8192), 16, 0, 0); } while (0)
#define PG8_LDA(dst, b, h) do { _Pragma("unroll") for (int m = 0; m < 4; ++m) _Pragma("unroll") for (int k = 0; k < 2; ++k) dst[m][k] = *(const PG8_LAS bf16x8*)(lds + PG8_SA(b, h) + aoff + m * 2048 + k * 1024); } while (0)
#define PG8_LDB(dst, b, h) do { _Pragma("unroll") for (int n = 0; n < 2; ++n) _Pragma("unroll") for (int k = 0; k < 2; ++k) dst[n][k] = *(const PG8_LAS bf16x8*)(lds + PG8_SB(b, h) + boff + n * 2048 + k * 1024); } while (0)
#define PG8_MMA(ai, bj, At, Bt) do { __builtin_amdgcn_s_setprio(1); _Pragma("unroll") for (int m = 0; m < 4; ++m) _Pragma("unroll") for (int n = 0; n < 2; ++n) _Pragma("unroll") for (int k = 0; k < 2; ++k) \
        acc[ai][bj][m][n] = __builtin_amdgcn_mfma_f32_16x16x32_bf16(Bt[n][k], At[m][k], acc[ai][bj][m][n], 0, 0, 0); __builtin_amdgcn_s_setprio(0); } while (0)
#define PG8_WAIT_V(n) asm volatile("s_waitcnt vmcnt(" #n ")" ::: "memory")
#define PG8_WAIT_L(n) asm volatile("s_waitcnt lgkmcnt(" #n ")" ::: "memory")
#define PG8_BAR __builtin_amdgcn_s_barrier()
#define PG8_SCHED __builtin_amdgcn_sched_barrier(0)
    Unit cur, nxt; int ui = 0;
    if (!S.next(0, cur)) return;
    f32x4 acc[2][2][4][2];
#pragma unroll
    for (int a = 0; a < 2; ++a)
#pragma unroll
        for (int b = 0; b < 2; ++b)
#pragma unroll
            for (int m = 0; m < 4; ++m)
#pragma unroll
                for (int n = 0; n < 2; ++n) acc[a][b][m][n] = (f32x4){0.f, 0.f, 0.f, 0.f};
    bf16x8 At[4][2], B0[2][2], B1[2][2];
    const char* cA = (const char*)g.A + (size_t)cur.pm * tstep; const char* cB = (const char*)g.Bt + (size_t)cur.pn * tstep;
    S.a_ready(cur);
    if constexpr (SP2) {
        PG8_STAGE(PG8_SB(0, 0), cB, voffB); PG8_STAGE(PG8_SB(0, 1), cB + hstep, voffB); PG8_STAGE(PG8_SA(0, 0), cA, voffA); PG8_STAGE(PG8_SA(0, 1), cA + hstep, voffA);
        if (wr == 1) PG8_BAR;
        PG8_WAIT_V(2); PG8_BAR;
        PG8_STAGE(PG8_SB(1, 0), cB + kstep, voffB); PG8_STAGE(PG8_SA(1, 0), cA + kstep, voffA); PG8_STAGE(PG8_SB(1, 1), cB + hstep + kstep, voffB);
        PG8_WAIT_V(6); PG8_BAR;
    } else {
        PG8_STAGE(PG8_SB(0, 0), cB, voffB); PG8_STAGE(PG8_SA(0, 0), cA, voffA); PG8_STAGE(PG8_SB(0, 1), cB + hstep, voffB); PG8_STAGE(PG8_SA(0, 1), cA + hstep, voffA);
        if (wr == 1) PG8_BAR;
        PG8_WAIT_V(4); PG8_BAR;
        PG8_STAGE(PG8_SB(1, 0), cB + kstep, voffB); PG8_STAGE(PG8_SA(1, 0), cA + kstep, voffA); PG8_STAGE(PG8_SB(1, 1), cB + hstep + kstep, voffB);
        PG8_WAIT_V(6); PG8_BAR;
    }
    for (;;) {
        const bool has_next = S.next(ui + 1, nxt);
        const char* nA = has_next ? (const char*)g.A + (size_t)nxt.pm * tstep : cA; const char* nB = has_next ? (const char*)g.Bt + (size_t)nxt.pn * tstep : cB;
        for (int t = 0; t < nt; t += 2) {
            const bool last = (t == nt - 2);
            const char* a1 = cA + (size_t)(t + 1) * kstep;
            const char* a2 = last ? nA : cA + (size_t)(t + 2) * kstep; const char* b2 = last ? nB : cB + (size_t)(t + 2) * kstep;
            const char* a3 = a2 + kstep; const char* b3 = b2 + kstep;
            if (last && has_next) S.a_ready(nxt);
            if constexpr (SP2) {
            PG8_LDB(B0, 0, 0); PG8_LDB(B1, 0, 1); PG8_SCHED; PG8_LDA(At, 0, 0); PG8_STAGE(PG8_SA(1, 1), a1 + hstep, voffA);
            PG8_WAIT_V(8); PG8_WAIT_L(0); PG8_BAR; PG8_MMA(0, 0, At, B0); PG8_MMA(0, 1, At, B1); PG8_BAR; PG8_SCHED;
            PG8_LDA(At, 0, 1); PG8_STAGE(PG8_SB(0, 0), b2, voffB); PG8_STAGE(PG8_SB(0, 1), b2 + hstep, voffB); PG8_STAGE(PG8_SA(0, 0), a2, voffA);
            PG8_WAIT_V(8); PG8_WAIT_L(0); PG8_BAR; PG8_MMA(1, 0, At, B0); PG8_MMA(1, 1, At, B1); PG8_BAR; PG8_SCHED;
            PG8_LDB(B0, 1, 0); PG8_LDB(B1, 1, 1); PG8_SCHED; PG8_LDA(At, 1, 0); PG8_STAGE(PG8_SA(0, 1), a2 + hstep, voffA);
            PG8_WAIT_V(8); PG8_WAIT_L(0); PG8_BAR; PG8_MMA(0, 0, At, B0); PG8_MMA(0, 1, At, B1); PG8_BAR; PG8_SCHED;
            PG8_LDA(At, 1, 1); PG8_STAGE(PG8_SB(1, 0), b3, voffB); PG8_STAGE(PG8_SB(1, 1), b3 + hstep, voffB); PG8_STAGE(PG8_SA(1, 0), a3, voffA);
            PG8_WAIT_V(8); PG8_WAIT_L(0); PG8_BAR; PG8_MMA(1, 0, At, B0); PG8_MMA(1, 1, At, B1); PG8_BAR; PG8_SCHED;
            } else {
            PG8_LDB(B0, 0, 0); PG8_SCHED; PG8_LDA(At, 0, 0); PG8_STAGE(PG8_SA(1, 1), a1 + hstep, voffA);
            PG8_WAIT_L(8); PG8_BAR; PG8_WAIT_L(0); PG8_MMA(0, 0, At, B0); PG8_BAR; PG8_SCHED;
            PG8_LDB(B1, 0, 1); PG8_STAGE(PG8_SB(0, 0), b2, voffB);
            PG8_BAR; PG8_WAIT_L(0); PG8_MMA(0, 1, At, B1); PG8_BAR;
            PG8_LDA(At, 0, 1); PG8_STAGE(PG8_SA(0, 0), a2, voffA);
            PG8_BAR; PG8_WAIT_L(0); PG8_MMA(1, 0, At, B0); PG8_BAR; PG8_SCHED;
            PG8_STAGE(PG8_SB(0, 1), b2 + hstep, voffB);
            PG8_WAIT_V(6); PG8_BAR; PG8_MMA(1, 1, At, B1); PG8_BAR;
            PG8_LDB(B0, 1, 0); PG8_SCHED; PG8_LDA(At, 1, 0); PG8_STAGE(PG8_SA(0, 1), a2 + hstep, voffA);
            PG8_WAIT_L(8); PG8_BAR; PG8_WAIT_L(0); PG8_MMA(0, 0, At, B0); PG8_BAR; PG8_SCHED;
            PG8_LDB(B1, 1, 1); PG8_STAGE(PG8_SB(1, 0), b3, voffB);
            PG8_BAR; PG8_WAIT_L(0); PG8_MMA(0, 1, At, B1); PG8_BAR;
            PG8_LDA(At, 1, 1); PG8_STAGE(PG8_SA(1, 0), a3, voffA);
            PG8_BAR; PG8_WAIT_L(0); PG8_MMA(1, 0, At, B0); PG8_BAR; PG8_SCHED;
            PG8_STAGE(PG8_SB(1, 1), b3 + hstep, voffB);
            PG8_WAIT_V(6); PG8_BAR; PG8_MMA(1, 1, At, B1); PG8_BAR;
            }
        }
        if constexpr (ALIGN_EPI) { if (wr == 0) PG8_BAR; }
        if constexpr (!Epi::AFTER_DRAIN) { E(acc, cur, wr, wc, fr, fq); S.done(cur); }
        if (!has_next) break;
#pragma unroll
        for (int a = 0; a < 2; ++a)
#pragma unroll
            for (int b = 0; b < 2; ++b)
#pragma unroll
                for (int m = 0; m < 4; ++m)
#pragma unroll
                    for (int n = 0; n < 2; ++n) acc[a][b][m][n] = (f32x4){0.f, 0.f, 0.f, 0.f};
        cur = nxt; cA = nA; cB = nB; ++ui;
        if constexpr (ALIGN_EPI) { if (wr == 1) PG8_BAR; }
    }
    PG8_WAIT_V(0);
    if constexpr (!ALIGN_EPI) { if (wr == 0) PG8_BAR; }
    PG8_BAR;
    if constexpr (Epi::AFTER_DRAIN) { E.fused(acc, cur, wr, wc, fr, fq, lds, wid, lane); S.done(cur); }
#undef PG8_SA
#undef PG8_SB
#undef PG8_STAGE
#undef PG8_LDA
#undef PG8_LDB
#undef PG8_MMA
#undef PG8_WAIT_V
#undef PG8_WAIT_L
#undef PG8_BAR
#undef PG8_SCHED
}
}

namespace cg = cooperative_groups;
#define GAS __attribute__((address_space(1)))
#define LAS __attribute__((address_space(3)))
typedef unsigned short bf16;
typedef unsigned v4u __attribute__((ext_vector_type(4)));
typedef unsigned v2u __attribute__((ext_vector_type(2)));
typedef float f32x4 __attribute__((ext_vector_type(4)));
typedef float f32x16 __attribute__((ext_vector_type(16)));
typedef short bf16x8 __attribute__((ext_vector_type(8)));
typedef short s16x4 __attribute__((ext_vector_type(4)));
typedef float f32x2_t __attribute__((ext_vector_type(2)));
typedef __bf16 bf16x2_t __attribute__((ext_vector_type(2)));
#define LDS_WAIT() asm volatile("s_waitcnt lgkmcnt(0)" ::: "memory")

constexpr int NWAVES = 8;
constexpr int BATCH = 4, SEQ = 4096, D = 1024, M = BATCH * SEQ, INC = 3072, FF = 4096, PLE = 256, WCONV = 512, NH = 8, HD = 64;
constexpr int QOFF = 1536, KOFF = 2048, VOFF = 2560;
constexpr float EPS = 1e-6f;
constexpr size_t MiB = 1u << 20;
constexpr size_t WS_SS1 = 1 * MiB, WS_SS2 = 2 * MiB;
constexpr size_t WS_WIN = 4 * MiB, WS_WOUT = 10 * MiB, WS_WUP = 12 * MiB, WS_WDN = 20 * MiB, WS_WG = 28 * MiB, WS_WPP = 30 * MiB;
constexpr size_t WS_PB = 31 * MiB;
constexpr size_t WS_XN = 40 * MiB;
constexpr size_t WS_HB = 72 * MiB;
constexpr size_t WS_PROJ = 104 * MiB;
constexpr size_t WS_END = 232 * MiB;

__device__ __forceinline__ unsigned f2bf(float f) { unsigned u = __builtin_bit_cast(unsigned, f); return (u + 0x7fffu + ((u >> 16) & 1u)) >> 16; }
__device__ __forceinline__ unsigned pk2(float lo, float hi) { f32x2_t v = {lo, hi}; bf16x2_t b = __builtin_convertvector(v, bf16x2_t); return __builtin_bit_cast(unsigned, b); }
__device__ __forceinline__ float bflo(unsigned w) { return __uint_as_float(w << 16); }
__device__ __forceinline__ float bfhi(unsigned w) { return __uint_as_float(w & 0xffff0000u); }
__device__ __forceinline__ float wave_sum(float v) {
#pragma unroll
    for (int o = 1; o < 64; o <<= 1) v += __shfl_xor(v, o);
    return v;
}
__device__ __forceinline__ void p0_transpose_item(const float* W, const float* g, int K, int N, bf16* WT, LAS float* scr, int item, int lane) {
    const int nblk = N / 32, kb = item / nblk, nb = item % nblk, k0 = 64 * kb, n0 = 32 * nb;
#pragma unroll 8
    for (int i = 0; i < 32; ++i) { const int kk = 2 * i + (lane >> 5); const float gv = g ? g[k0 + kk] : 1.0f; scr[kk * 33 + (lane & 31)] = W[(size_t)(k0 + kk) * N + n0 + (lane & 31)] * gv; }
    LDS_WAIT(); asm volatile("" ::: "memory");
    const int c = lane & 7;
#pragma unroll
    for (int j = 0; j < 4; ++j) { const int n = (lane >> 3) + 8 * j; const LAS float* s = scr + (8 * c) * 33 + n;
        v4u o; o.x = pk2(s[0 * 33], s[1 * 33]); o.y = pk2(s[2 * 33], s[3 * 33]); o.z = pk2(s[4 * 33], s[5 * 33]); o.w = pk2(s[6 * 33], s[7 * 33]);
        *(GAS v4u*)(WT + (size_t)(n0 + n) * K + k0 + 8 * c) = o; }
    LDS_WAIT(); asm volatile("" ::: "memory");
}
__device__ __forceinline__ void rms_row_to_bf16(const float* xrow, const float* g, bf16* orow, int lane) {
    const GAS f32x4* xr = (const GAS f32x4*)xrow + lane; const GAS f32x4* gr = (const GAS f32x4*)g + lane;
    f32x4 v[4]; float s = 0.f;
#pragma unroll
    for (int j = 0; j < 4; ++j) { v[j] = xr[64 * j]; s += (v[j].x * v[j].x + v[j].y * v[j].y) + (v[j].z * v[j].z + v[j].w * v[j].w); }
    const float rs = 1.f / sqrtf(wave_sum(s) * (1.f / D) + EPS);
    GAS v2u* o8 = (GAS v2u*)orow + lane;
#pragma unroll
    for (int j = 0; j < 4; ++j) { const f32x4 gg = gr[64 * j]; v2u w; w.x = pk2(v[j].x * rs * gg.x, v[j].y * rs * gg.y); w.y = pk2(v[j].z * rs * gg.z, v[j].w * rs * gg.w); o8[64 * j] = w; }
}
__device__ __forceinline__ void rms_row_final(float* xrow, const float* g, int lane) {
    GAS f32x4* xr = (GAS f32x4*)xrow + lane; const GAS f32x4* gr = (const GAS f32x4*)g + lane;
    f32x4 v[4]; float s = 0.f;
#pragma unroll
    for (int j = 0; j < 4; ++j) { v[j] = xr[64 * j]; s += (v[j].x * v[j].x + v[j].y * v[j].y) + (v[j].z * v[j].z + v[j].w * v[j].w); }
    const float rs = 1.f / sqrtf(wave_sum(s) * (1.f / D) + EPS);
#pragma unroll
    for (int j = 0; j < 4; ++j) { const f32x4 gg = gr[64 * j]; xr[64 * j] = v[j] * rs * gg; }
}

__device__ __forceinline__ void unpack8(const v4u w, float (&f)[8]) { f[0] = bflo(w.x); f[1] = bfhi(w.x); f[2] = bflo(w.y); f[3] = bfhi(w.y); f[4] = bflo(w.z); f[5] = bfhi(w.z); f[6] = bflo(w.w); f[7] = bfhi(w.w); }
__device__ __forceinline__ void conv_chunk(const bf16* PROJ, bf16* MIX, const float* cw, const float* gco, int row0, int lane) {
    const int c0 = lane * 8;
    float w0[8], w1[8], w2[8], gg[8];
#pragma unroll
    for (int j = 0; j < 8; ++j) { w0[j] = cw[c0 + j]; w1[j] = cw[WCONV + c0 + j]; w2[j] = cw[2 * WCONV + c0 + j]; gg[j] = gco[c0 + j]; }
    float vm2[8], vm1[8];
#pragma unroll
    for (int j = 0; j < 8; ++j) { vm2[j] = 0.f; vm1[j] = 0.f; }
    if ((row0 & (SEQ - 1)) != 0) {
        float a[8], b[8];
        const bf16* p2 = PROJ + (size_t)(row0 - 2) * INC + c0; const bf16* p1 = PROJ + (size_t)(row0 - 1) * INC + c0;
        unpack8(*(const GAS v4u*)(p2 + 512), a); unpack8(*(const GAS v4u*)(p2 + 1024), b);
#pragma unroll
        for (int j = 0; j < 8; ++j) vm2[j] = a[j] * b[j];
        unpack8(*(const GAS v4u*)(p1 + 512), a); unpack8(*(const GAS v4u*)(p1 + 1024), b);
#pragma unroll
        for (int j = 0; j < 8; ++j) vm1[j] = a[j] * b[j];
    }
#pragma unroll 2
    for (int i = 0; i < 8; ++i) {
        const bf16* pr = PROJ + (size_t)(row0 + i) * INC + c0;
        float cb[8], cc[8], cu[8], y[8];
        unpack8(*(const GAS v4u*)(pr), cb); unpack8(*(const GAS v4u*)(pr + 512), cc); unpack8(*(const GAS v4u*)(pr + 1024), cu);
        float ss = 0.f;
#pragma unroll
        for (int j = 0; j < 8; ++j) { const float v = cc[j] * cu[j]; y[j] = cb[j] * (w0[j] * vm2[j] + w1[j] * vm1[j] + w2[j] * v); ss += y[j] * y[j]; vm2[j] = vm1[j]; vm1[j] = v; }
        ss += __shfl_xor(ss, 1); ss += __shfl_xor(ss, 2); ss += __shfl_xor(ss, 4);
        const float rs = 1.f / sqrtf(ss * (1.f / HD) + EPS);
        v4u o; o.x = pk2(y[0] * rs * gg[0], y[1] * rs * gg[1]); o.y = pk2(y[2] * rs * gg[2], y[3] * rs * gg[3]); o.z = pk2(y[4] * rs * gg[4], y[5] * rs * gg[5]); o.w = pk2(y[6] * rs * gg[6], y[7] * rs * gg[7]);
        *(GAS v4u*)(MIX + (size_t)(row0 + i) * D + c0) = o;
    }
}

__device__ __forceinline__ int crow(int r, int hi) { return (r & 3) + 8 * (r >> 2) + 4 * hi; }
constexpr int VPITCH = 144;
__device__ __forceinline__ void sb_unit(const bf16* PROJ, bf16* MIX, const float* gattn, int b, int h, int qt, LAS unsigned char* vl, int lane) {
    const int r = lane & 31, hh = lane >> 5;
    const size_t rowbase = (size_t)b * SEQ;
    const bf16* qp = PROJ + (rowbase + qt * 32 + r) * INC + QOFF + h * HD + 8 * hh;
    bf16x8 qf[4];
#pragma unroll
    for (int d0 = 0; d0 < 4; ++d0) qf[d0] = *(const GAS bf16x8*)(qp + d0 * 16);
    f32x16 o0, o1;
#pragma unroll
    for (int i = 0; i < 16; ++i) { o0[i] = 0.f; o1[i] = 0.f; }
    float R = 0.f;
    const float SC = 0.125f * 1.4426950408889634f;
    const bf16* kbase = PROJ + (rowbase + r) * INC + KOFF + h * HD + 8 * hh;
    const bf16* vbase = PROJ + (rowbase + (lane >> 3)) * INC + VOFF + h * HD + (lane & 7) * 8;
    bf16x8 kf[4]; v4u vv[4];
#define SB_LOADT(t) do { const bf16* kp_ = kbase + (size_t)(t) * 32 * INC; const bf16* vp_ = vbase + (size_t)(t) * 32 * INC; \
        _Pragma("unroll") for (int d0 = 0; d0 < 4; ++d0) kf[d0] = *(const GAS bf16x8*)(kp_ + d0 * 16); \
        _Pragma("unroll") for (int i = 0; i < 4; ++i) vv[i] = *(const GAS v4u*)(vp_ + (size_t)(8 * i) * INC); } while (0)
    SB_LOADT(qt);
    const int i16 = lane & 15, q4 = i16 >> 2, p4 = i16 & 3, blk = (lane >> 4) & 1;
    LAS unsigned char* vrd = vl + (4 * hh + q4) * VPITCH + blk * 32 + p4 * 8;
    LAS unsigned char* vwr = vl + (lane >> 3) * VPITCH + (lane & 7) * 16;
    for (int kt = qt; kt >= 0; --kt) {
        bf16x8 kc[4]; v4u vc[4];
#pragma unroll
        for (int i = 0; i < 4; ++i) { kc[i] = kf[i]; vc[i] = vv[i]; }
        if (kt > 0) SB_LOADT(kt - 1);
#pragma unroll
        for (int i = 0; i < 4; ++i) *(LAS v4u*)(vwr + 8 * i * VPITCH) = vc[i];
        f32x16 s;
#pragma unroll
        for (int i = 0; i < 16; ++i) s[i] = 0.f;
#pragma unroll
        for (int d0 = 0; d0 < 4; ++d0) s = __builtin_amdgcn_mfma_f32_32x32x16_bf16(kc[d0], qf[d0], s, 0, 0, 0);
        float z2[16], lk[16], p[16];
        const bool diag = (kt == qt);
#pragma unroll
        for (int i = 0; i < 16; ++i) { z2[i] = s[i] * SC; const float e = __builtin_amdgcn_exp2f(-fabsf(z2[i])); const float l = __builtin_amdgcn_logf(1.0f + e); lk[i] = -(fmaxf(z2[i], 0.f) + l); }
        if (diag) {
#pragma unroll
            for (int i = 0; i < 16; ++i) if (crow(i, hh) >= r) lk[i] = 0.f;
        }
        float g[4], og[4], tot[4], T[4];
#pragma unroll
        for (int a = 0; a < 4; ++a) { g[a] = (lk[4 * a] + lk[4 * a + 1]) + (lk[4 * a + 2] + lk[4 * a + 3]); og[a] = __shfl_xor(g[a], 32); tot[a] = g[a] + og[a]; }
        T[3] = R; T[2] = T[3] + tot[3]; T[1] = T[2] + tot[2]; T[0] = T[1] + tot[1];
        const float Rn = T[0] + tot[0];
        if (hh == 0) {
#pragma unroll
            for (int a = 0; a < 4; ++a) T[a] += og[a];
        }
#pragma unroll
        for (int a = 0; a < 4; ++a) { const float c3 = T[a], c2 = c3 + lk[4 * a + 3], c1 = c2 + lk[4 * a + 2], c0 = c1 + lk[4 * a + 1];
            p[4 * a + 3] = __builtin_amdgcn_exp2f(z2[4 * a + 3] + lk[4 * a + 3] + c3); p[4 * a + 2] = __builtin_amdgcn_exp2f(z2[4 * a + 2] + lk[4 * a + 2] + c2);
            p[4 * a + 1] = __builtin_amdgcn_exp2f(z2[4 * a + 1] + lk[4 * a + 1] + c1); p[4 * a] = __builtin_amdgcn_exp2f(z2[4 * a] + lk[4 * a] + c0); }
        if (diag) {
#pragma unroll
            for (int i = 0; i < 16; ++i) if (crow(i, hh) >= r) p[i] = 0.f;
        }
        R = Rn;
        v4u pw0, pw1;
        pw0.x = pk2(p[0], p[1]); pw0.y = pk2(p[2], p[3]); pw0.z = pk2(p[4], p[5]); pw0.w = pk2(p[6], p[7]);
        pw1.x = pk2(p[8], p[9]); pw1.y = pk2(p[10], p[11]); pw1.z = pk2(p[12], p[13]); pw1.w = pk2(p[14], p[15]);
        const bf16x8 pf0 = __builtin_bit_cast(bf16x8, pw0), pf1 = __builtin_bit_cast(bf16x8, pw1);
        asm volatile("" ::: "memory");
#define SB_VTR(off) __builtin_bit_cast(s16x4, __builtin_amdgcn_ds_read_tr16_b64_v4i16((LAS s16x4*)(vrd + (off))))
#pragma unroll
        for (int sk = 0; sk < 2; ++sk) {
            const s16x4 l0 = SB_VTR(16 * sk * VPITCH), h0 = SB_VTR((16 * sk + 8) * VPITCH), l1 = SB_VTR(16 * sk * VPITCH + 64), h1 = SB_VTR((16 * sk + 8) * VPITCH + 64);
            const bf16x8 v0 = __builtin_shufflevector(l0, h0, 0, 1, 2, 3, 4, 5, 6, 7), v1 = __builtin_shufflevector(l1, h1, 0, 1, 2, 3, 4, 5, 6, 7);
            o0 = __builtin_amdgcn_mfma_f32_32x32x16_bf16(v0, sk ? pf1 : pf0, o0, 0, 0, 0);
            o1 = __builtin_amdgcn_mfma_f32_32x32x16_bf16(v1, sk ? pf1 : pf0, o1, 0, 0, 0);
        }
        asm volatile("" ::: "memory");
        if (__all(R < -150.0f)) break;
    }
#undef SB_VTR
#undef SB_LOADT
    float ss = 0.f;
#pragma unroll
    for (int i = 0; i < 16; ++i) ss += o0[i] * o0[i] + o1[i] * o1[i];
    ss += __shfl_xor(ss, 32);
    const float rs = 1.f / sqrtf(ss * (1.f / HD) + EPS);
    bf16* op = MIX + (rowbase + qt * 32 + r) * D + WCONV + h * HD + 4 * hh;
    const float* gp = gattn + h * HD + 4 * hh;
#pragma unroll
    for (int a = 0; a < 4; ++a) {
        const f32x4 g0 = *(const GAS f32x4*)(gp + 8 * a), g1 = *(const GAS f32x4*)(gp + 32 + 8 * a);
        v2u w0, w1;
        w0.x = pk2(o0[4 * a] * rs * g0.x, o0[4 * a + 1] * rs * g0.y); w0.y = pk2(o0[4 * a + 2] * rs * g0.z, o0[4 * a + 3] * rs * g0.w);
        w1.x = pk2(o1[4 * a] * rs * g1.x, o1[4 * a + 1] * rs * g1.y); w1.y = pk2(o1[4 * a + 2] * rs * g1.z, o1[4 * a + 3] * rs * g1.w);
        *(GAS v2u*)(op + 8 * a) = w0; *(GAS v2u*)(op + 32 + 8 * a) = w1;
    }
}

constexpr int LDS_BYTES = 147456;
struct Args { const float* in[15]; float* out; unsigned char* ws; };
__global__ void __launch_bounds__(NWAVES * 64, 2) hymba_fwd(Args args) {
    extern __shared__ __attribute__((aligned(16))) unsigned char lds_raw[];
    cg::grid_group grid = cg::this_grid();
    LAS unsigned char* lds = (LAS unsigned char*)lds_raw;
    const int tid = threadIdx.x, lane = tid & 63, wave = __builtin_amdgcn_readfirstlane(tid >> 6);
    const int G = gridDim.x; const int bx = blockIdx.x; const int vcu = (G % 8 == 0) ? (bx % 8) * (G / 8) + bx / 8 : bx;
    const int gw = vcu * NWAVES + wave, NGW = G * NWAVES;
    const float* x = args.in[0]; const float* pin = args.in[1]; const float* g_mix = args.in[2]; const float* w_in = args.in[3]; const float* conv_w = args.in[4];
    const float* g_conv = args.in[5]; const float* g_attn = args.in[6]; const float* w_out = args.in[7]; const float* g_mlp = args.in[8]; const float* w_up = args.in[9];
    const float* w_down = args.in[10]; const float* g_ple = args.in[11]; const float* w_gate = args.in[12]; const float* w_pp = args.in[13]; const float* g_final = args.in[14];
    float* out = args.out; unsigned char* ws = args.ws;
    float* SS1 = (float*)(ws + WS_SS1); float* SS2 = (float*)(ws + WS_SS2);
    bf16* WIN = (bf16*)(ws + WS_WIN); bf16* WOUT = (bf16*)(ws + WS_WOUT); bf16* WUP = (bf16*)(ws + WS_WUP); bf16* WDN = (bf16*)(ws + WS_WDN); bf16* WG = (bf16*)(ws + WS_WG); bf16* WPP = (bf16*)(ws + WS_WPP);
    bf16* PB = (bf16*)(ws + WS_PB); bf16* XN = (bf16*)(ws + WS_XN); bf16* HB = (bf16*)(ws + WS_HB); bf16* PROJ = (bf16*)(ws + WS_PROJ);
    bf16* MIX = XN; bf16* PP = XN; bf16* U = PROJ;

    {
        LAS float* scr = (LAS float*)(lds + wave * 16384);
        constexpr int I_IN = (D / 64) * (INC / 32), I_OUT = (D / 64) * (D / 32), I_UP = (D / 64) * (FF / 32), I_DN = (FF / 64) * (D / 32), I_G = I_OUT, I_PP = (PLE / 64) * (D / 32);
        constexpr int NITEMS = I_IN + I_OUT + I_UP + I_DN + I_G + I_PP;
        for (int it = gw; it < NITEMS; it += NGW) {
            int r = it;
            if (r < I_IN) { p0_transpose_item(w_in, nullptr, D, INC, WIN, scr, r, lane); continue; } r -= I_IN;
            if (r < I_OUT) { p0_transpose_item(w_out, nullptr, D, D, WOUT, scr, r, lane); continue; } r -= I_OUT;
            if (r < I_UP) { p0_transpose_item(w_up, g_mlp, D, FF, WUP, scr, r, lane); continue; } r -= I_UP;
            if (r < I_DN) { p0_transpose_item(w_down, nullptr, FF, D, WDN, scr, r, lane); continue; } r -= I_DN;
            if (r < I_G) { p0_transpose_item(w_gate, g_ple, D, D, WG, scr, r, lane); continue; } r -= I_G;
            p0_transpose_item(w_pp, nullptr, PLE, D, WPP, scr, r, lane);
        }
        for (int m = gw; m < M; m += NGW) rms_row_to_bf16(x + (size_t)m * D, g_mix, XN + (size_t)m * D, lane);
        for (int i = gw * 64 + lane; i < M * PLE / 8; i += NGW * 64) {
            const f32x4 a = *(const GAS f32x4*)(pin + (size_t)i * 8), b = *(const GAS f32x4*)(pin + (size_t)i * 8 + 4);
            v4u o; o.x = pk2(a.x, a.y); o.y = pk2(a.z, a.w); o.z = pk2(b.x, b.y); o.w = pk2(b.z, b.w);
            *(GAS v4u*)(PB + (size_t)i * 8) = o;
        }
    }
    grid.sync();
    {
        pg8::Gemm g{XN, WIN, M, INC, D}; pg8::StaticOrder S; S.init(M, INC, G, bx);
        pg8::EpiBf16 E{PROJ, INC};
        pg8::gemm_phase<pg8::EpiBf16, pg8::StaticOrder, true, true>(lds, g, S, E);
    }
    grid.sync();
    {
        for (int c = gw; c < M / 8; c += NGW) conv_chunk(PROJ, MIX, conv_w, g_conv, c * 8, lane);
        LAS unsigned char* vl = lds + wave * 8192;
        for (int u = gw; u < BATCH * NH * (SEQ / 32); u += NGW) { const int bh = u / (SEQ / 32), qt = u % (SEQ / 32); sb_unit(PROJ, MIX, g_attn, bh / NH, bh % NH, qt, vl, lane); }
    }
    grid.sync();
    {
        pg8::Gemm g{MIX, WOUT, M, D, D}; pg8::StaticOrder S; S.init(M, D, G, bx);
        pg8::EpiRes E{x, out, HB, D, SS1, M};
        pg8::gemm_phase<pg8::EpiRes, pg8::StaticOrder, true, true>(lds, g, S, E);
    }
    grid.sync();
    {
        pg8::Gemm g{HB, WUP, M, FF, D}; pg8::StaticOrder S; S.init(M, FF, G, bx);
        pg8::EpiUp E{U, FF, SS1, M, EPS};
        pg8::gemm_phase<pg8::EpiUp, pg8::StaticOrder, true, true>(lds, g, S, E);
    }
    grid.sync();
    {
        pg8::Gemm g{U, WDN, M, D, FF}; pg8::StaticOrder S; S.init(M, D, G, bx);
        pg8::EpiRes E{out, out, HB, D, SS2, M};
        pg8::gemm_phase<pg8::EpiRes, pg8::StaticOrder, true, true>(lds, g, S, E);
    }
    {
        pg8::Gemm g{PB, WPP, M, D, PLE}; pg8::StaticOrder S; S.init(M, D, G, bx);
        pg8::EpiBf16 E{PP, D};
        pg8::gemm_phase<pg8::EpiBf16, pg8::StaticOrder, true, true>(lds, g, S, E);
    }
    grid.sync();
    {
        pg8::Gemm g{HB, WG, M, D, D}; pg8::StaticOrder S; S.init(M, D, G, bx);
        pg8::EpiGate E{out, out, PP, D, SS2, M, EPS};
        pg8::gemm_phase<pg8::EpiGate, pg8::StaticOrder, true, true>(lds, g, S, E);
    }
    grid.sync();
    for (int m = gw; m < M; m += NGW) rms_row_final(out + (size_t)m * D, g_final, lane);
}

extern "C" void kernel_launch(void* const* d_in, const int* in_sizes, int n_in, void* d_out, int out_size, void* d_ws, size_t ws_size, hipStream_t stream) {
    static int grid = 0;
    if (grid == 0) {
        if (n_in != 15 || in_sizes[0] != M * D || out_size != M * D || ws_size < WS_END) { fprintf(stderr, "kernel_launch: unexpected shapes (n_in %d, in0 %d, out %d, ws %zu); nothing launched\n", n_in, n_in > 0 ? in_sizes[0] : -1, out_size, ws_size); grid = -1; return; }
        int dev = 0, cus = 0, per_cu = 0;
        if (hipGetDevice(&dev) != hipSuccess || hipDeviceGetAttribute(&cus, hipDeviceAttributeMultiprocessorCount, dev) != hipSuccess) { fprintf(stderr, "kernel_launch: device query failed\n"); grid = -1; return; }
        if (hipFuncSetAttribute((const void*)hymba_fwd, hipFuncAttributeMaxDynamicSharedMemorySize, LDS_BYTES) != hipSuccess) { fprintf(stderr, "kernel_launch: hipFuncSetAttribute failed\n"); grid = -1; return; }
        if (hipOccupancyMaxActiveBlocksPerMultiprocessor(&per_cu, (const void*)hymba_fwd, NWAVES * 64, LDS_BYTES) != hipSuccess || per_cu < 1) { fprintf(stderr, "kernel_launch: occupancy query gave %d\n", per_cu); per_cu = 1; }
        (void)hipGetLastError();
        grid = cus * per_cu;
    }
    if (grid < 0) return;
    Args a{};
    for (int i = 0; i < 15; ++i) a.in[i] = (const float*)d_in[i];
    a.out = (float*)d_out; a.ws = (unsigned char*)d_ws;
    void* kargs[] = {&a};
    const hipError_t e = hipLaunchCooperativeKernel((const void*)hymba_fwd, dim3(grid), dim3(NWAVES * 64), kargs, LDS_BYTES, stream);
    if (e != hipSuccess) fprintf(stderr, "kernel_launch: cooperative launch failed: %s (grid %d)\n", hipGetErrorString(e), grid);
}
```

```cpp
#include <hip/hip_runtime.h>
#include <hip/hip_cooperative_groups.h>
#include <cstdio>
#include <cstdint>
namespace pg8 {
#define PG8_LAS __attribute__((address_space(3)))
typedef unsigned short bf16_t;
typedef short bf16x8 __attribute__((ext_vector_type(8)));
typedef float f32x4 __attribute__((ext_vector_type(4)));
typedef unsigned u32x4 __attribute__((ext_vector_type(4)));
constexpr int BM = 256, BK = 64, HALF = 128, HTB = HALF * BK * 2  , STAGE_BYTES = 8 * HTB, NXCD = 8, WGM = 8;

__host__ __device__ __forceinline__ int lds_byte(int r, int c) { const int st = (r >> 4) * 2 + (c >> 5), rr = r & 15, cc = c & 31, ob = rr * 64 + cc * 2; return st * 1024 + (ob ^ (((ob >> 9) & 1) << 5)); }
__host__ __device__ __forceinline__ void stage_rc(int b, int& R, int& C) { const int st = b / 1024, sb = b % 1024, swz = sb ^ (((sb >> 9) & 1) << 5); R = (st >> 1) * 16 + swz / 64; C = (st & 1) * 32 + (swz % 64) / 2; }
__host__ __device__ __forceinline__ int perm32(int rho) { const int n = rho >> 4, i = rho & 15; return 8 * (i >> 2) + 4 * n + (i & 3); }

struct Unit { int pm, pn; };
struct Gemm { const bf16_t* A; const bf16_t* Bt; int M, N, K; };

struct StaticOrder {
    int nM, nN, nwg, G, c;
    __host__ __device__ void init(int M, int N, int G_, int c_) { nM = M / BM; nN = N / BM; nwg = nM * nN; G = G_; c = c_; }
    __host__ __device__ bool next(int i, Unit& u) const {
        const long L = (long)i * G + c; if (L >= nwg) return false;
        int wgid = (int)L; { const int q = nwg / NXCD, r = nwg % NXCD, xcd = wgid % NXCD, off = wgid / NXCD; wgid = (xcd < r ? xcd * (q + 1) : r * (q + 1) + (xcd - r) * q) + off; }
        const int nig = WGM * nN, gid = wgid / nig, fm = gid * WGM, gsz = (nM - fm) < WGM ? (nM - fm) : WGM;
        u.pm = fm + ((wgid % nig) % gsz); u.pn = (wgid % nig) / gsz; return true;
    }
    __device__ __forceinline__ void a_ready(const Unit&) const {}
    __device__ __forceinline__ void done(const Unit&) const {}
};

__device__ __forceinline__ unsigned cvt_pk_bf16(float lo, float hi) { unsigned r; asm volatile("v_cvt_pk_bf16_f32 %0, %1, %2" : "=v"(r) : "v"(lo), "v"(hi)); return r; }
typedef float f32x2 __attribute__((ext_vector_type(2)));
typedef unsigned u32x2 __attribute__((ext_vector_type(2)));
constexpr int NSS = 16;
__device__ __forceinline__ float row_rs(const float* ss, int M, int row, float eps) {
    float s = 0.f;
#pragma unroll
    for (int t = 0; t < NSS; ++t) s += ss[(size_t)t * M + row];
    return 1.0f / sqrtf(s * (1.0f / 1024.0f) + eps);
}
struct EpiBf16 {
    static constexpr bool PERM = true, AFTER_DRAIN = false;
    bf16_t* O; int ldc;
    __device__ __forceinline__ void operator()(const f32x4 (&acc)[2][2][4][2], const Unit& u, int wr, int wc, int fr, int fq) const {
        const int row0 = u.pm * BM + wr * 64 + fr, col0 = u.pn * BM + wc * 32 + 8 * fq;
#pragma unroll
        for (int ai = 0; ai < 2; ++ai)
#pragma unroll
            for (int m = 0; m < 4; ++m) { bf16_t* rowp = O + (size_t)(row0 + ai * HALF + m * 16) * ldc + col0;
#pragma unroll
                for (int bj = 0; bj < 2; ++bj) { const f32x4 v0 = acc[ai][bj][m][0], v1 = acc[ai][bj][m][1];
                    u32x4 w; w.x = cvt_pk_bf16(v0[0], v0[1]); w.y = cvt_pk_bf16(v0[2], v0[3]); w.z = cvt_pk_bf16(v1[0], v1[1]); w.w = cvt_pk_bf16(v1[2], v1[3]);
                    *(u32x4*)(rowp + bj * HALF) = w; } }
    }
};
struct EpiUp {
    static constexpr bool PERM = true, AFTER_DRAIN = false;
    bf16_t* O; int ldc; const float* ss; int M; float eps;
    __device__ __forceinline__ void operator()(const f32x4 (&acc)[2][2][4][2], const Unit& u, int wr, int wc, int fr, int fq) const {
        const int row0 = u.pm * BM + wr * 64 + fr, col0 = u.pn * BM + wc * 32 + 8 * fq;
#pragma unroll
        for (int ai = 0; ai < 2; ++ai)
#pragma unroll
            for (int m = 0; m < 4; ++m) { const int row = row0 + ai * HALF + m * 16; const float rs = row_rs(ss, M, row, eps); bf16_t* rowp = O + (size_t)row * ldc + col0;
#pragma unroll
                for (int bj = 0; bj < 2; ++bj) { f32x4 v0 = acc[ai][bj][m][0] * rs, v1 = acc[ai][bj][m][1] * rs;
#pragma unroll
                    for (int e = 0; e < 4; ++e) { const float a = fmaxf(v0[e], 0.f), b = fmaxf(v1[e], 0.f); v0[e] = a * a; v1[e] = b * b; }
                    u32x4 w; w.x = cvt_pk_bf16(v0[0], v0[1]); w.y = cvt_pk_bf16(v0[2], v0[3]); w.z = cvt_pk_bf16(v1[0], v1[1]); w.w = cvt_pk_bf16(v1[2], v1[3]);
                    *(u32x4*)(rowp + bj * HALF) = w; }
                asm volatile("" ::: "memory"); }
    }
};
struct EpiRes {
    static constexpr bool PERM = false, AFTER_DRAIN = false;
    const float* base; float* out; bf16_t* outb; int ldc; float* ss; int M;
    __device__ __forceinline__ void operator()(const f32x4 (&acc)[2][2][4][2], const Unit& u, int wr, int wc, int fr, int fq) const {
        const int col0 = u.pn * BM + wc * 32 + 4 * fq;
#pragma unroll
        for (int ai = 0; ai < 2; ++ai)
#pragma unroll
            for (int m = 0; m < 4; ++m) { const int row = u.pm * BM + ai * HALF + wr * 64 + m * 16 + fr; const size_t off = (size_t)row * ldc + col0; float q = 0.f;
#pragma unroll
                for (int bj = 0; bj < 2; ++bj)
#pragma unroll
                    for (int n = 0; n < 2; ++n) { const f32x4 bs = *(const f32x4*)(base + off + bj * HALF + n * 16); const f32x4 o = bs + acc[ai][bj][m][n];
                        *(f32x4*)(out + off + bj * HALF + n * 16) = o; u32x2 w; w.x = cvt_pk_bf16(o[0], o[1]); w.y = cvt_pk_bf16(o[2], o[3]); *(u32x2*)(outb + off + bj * HALF + n * 16) = w;
                        q += (o[0] * o[0] + o[1] * o[1]) + (o[2] * o[2] + o[3] * o[3]); }
                q += __shfl_xor(q, 16); q += __shfl_xor(q, 32);
                if (fq == 0) ss[(size_t)(u.pn * 4 + wc) * M + row] = q;
                asm volatile("" ::: "memory"); }
    }
};
struct EpiGate {
    static constexpr bool PERM = false, AFTER_DRAIN = false;
    const float* base; float* out; const bf16_t* pp; int ldc; const float* ss; int M; float eps;
    __device__ __forceinline__ void operator()(const f32x4 (&acc)[2][2][4][2], const Unit& u, int wr, int wc, int fr, int fq) const {
        const int col0 = u.pn * BM + wc * 32 + 4 * fq;
#pragma unroll
        for (int ai = 0; ai < 2; ++ai)
#pragma unroll
            for (int m = 0; m < 4; ++m) { const int row = u.pm * BM + ai * HALF + wr * 64 + m * 16 + fr; const size_t off = (size_t)row * ldc + col0; const float rs = row_rs(ss, M, row, eps);
#pragma unroll
                for (int bj = 0; bj < 2; ++bj)
#pragma unroll
                    for (int n = 0; n < 2; ++n) { const f32x4 bs = *(const f32x4*)(base + off + bj * HALF + n * 16); const u32x2 pw = *(const u32x2*)(pp + off + bj * HALF + n * 16);
                        const f32x4 a = acc[ai][bj][m][n] * rs;
                        f32x4 pv; pv[0] = __uint_as_float(pw.x << 16); pv[1] = __uint_as_float(pw.x & 0xffff0000u); pv[2] = __uint_as_float(pw.y << 16); pv[3] = __uint_as_float(pw.y & 0xffff0000u);
                        f32x4 o;
#pragma unroll
                        for (int e = 0; e < 4; ++e) { const float sg = __builtin_amdgcn_rcpf(1.0f + __expf(-a[e])); o[e] = bs[e] + sg * pv[e]; }
                        *(f32x4*)(out + off + bj * HALF + n * 16) = o; }
                asm volatile("" ::: "memory"); }
    }
};

template <class Epi, class Sched, bool ALIGN_EPI = false, bool SP2 = false>
__device__ __forceinline__ void gemm_phase(PG8_LAS unsigned char* lds, const Gemm g, const Sched& S, const Epi& E) {
    const int tid = threadIdx.x, wid = __builtin_amdgcn_readfirstlane(tid >> 6), lane = tid & 63, wr = wid >> 2, wc = wid & 3, fr = lane & 15, fq = lane >> 4;
    const int K = g.K, nt = K / BK;
    unsigned voffA[2], voffB[2];
#pragma unroll
    for (int i = 0; i < 2; ++i) { int R, C; stage_rc(tid * 16 + i * 8192, R, C); const int Rb = Epi::PERM ? ((R & ~31) + perm32(R & 31)) : R;
        voffA[i] = (unsigned)(R * K + C) * 2u; voffB[i] = (unsigned)(Rb * K + C) * 2u; }
    const size_t kstep = (size_t)(BK * 2);
    const size_t hstep = (size_t)HALF * K * 2;
    const size_t tstep = 2 * hstep;
    const unsigned ldsw = (unsigned)wid * 1024u;
    const int aoff = lds_byte(wr * 64 + fr, fq * 8), boff = lds_byte(wc * 32 + fr, fq * 8);
#define PG8_SA(b, h) (((b) * 2 + (h)) * HTB)
#define PG8_SB(b, h) ((4 + (b) * 2 + (h)) * HTB)
#define PG8_STAGE(bufoff, gbase, voff) do { _Pragma("unroll") for (int _i = 0; _i < 2; ++_i) \
        __builtin_amdgcn_global_load_lds((const unsigned*)((const char*)(gbase) + (voff)[_i]), (PG8_LAS unsigned*)(lds + (bufoff) + ldsw + _i * 8192), 16, 0, 0); } while (0)
#define PG8_LDA(dst, b, h) do { _Pragma("unroll") for (int m = 0; m < 4; ++m) _Pragma("unroll") for (int k = 0; k < 2; ++k) dst[m][k] = *(const PG8_LAS bf16x8*)(lds + PG8_SA(b, h) + aoff + m * 2048 + k * 1024); } while (0)
#define PG8_LDB(dst, b, h) do { _Pragma("unroll") for (int n = 0; n < 2; ++n) _Pragma("unroll") for (int k = 0; k < 2; ++k) dst[n][k] = *(const PG8_LAS bf16x8*)(lds + PG8_SB(b, h) + boff + n * 2048 + k * 1024); } while (0)
#define PG8_MMA(ai, bj, At, Bt) do { __builtin_amdgcn_s_setprio(1); _Pragma("unroll") for (int m = 0; m < 4; ++m) _Pragma("unroll") for (int n = 0; n < 2; ++n) _Pragma("unroll") for (int k = 0; k < 2; ++k) \
        acc[ai][bj][m][n] = __builtin_amdgcn_mfma_f32_16x16x32_bf16(Bt[n][k], At[m][k], acc[ai][bj][m][n], 0, 0, 0); __builtin_amdgcn_s_setprio(0); } while (0)
#define PG8_WAIT_V(n) asm volatile("s_waitcnt vmcnt(" #n ")" ::: "memory")
#define PG8_WAIT_L(n) asm volatile("s_waitcnt lgkmcnt(" #n ")" ::: "memory")
#define PG8_BAR __builtin_amdgcn_s_barrier()
#define PG8_SCHED __builtin_amdgcn_sched_barrier(0)
    Unit cur, nxt; int ui = 0;
    if (!S.next(0, cur)) return;
    f32x4 acc[2][2][4][2];
#pragma unroll
    for (int a = 0; a < 2; ++a)
#pragma unroll
        for (int b = 0; b < 2; ++b)
#pragma unroll
            for (int m = 0; m < 4; ++m)
#pragma unroll
                for (int n = 0; n < 2; ++n) acc[a][b][m][n] = (f32x4){0.f, 0.f, 0.f, 0.f};
    bf16x8 At[4][2], B0[2][2], B1[2][2];
    const char* cA = (const char*)g.A + (size_t)cur.pm * tstep; const char* cB = (const char*)g.Bt + (size_t)cur.pn * tstep;
    S.a_ready(cur);
    if constexpr (SP2) {
        PG8_STAGE(PG8_SB(0, 0), cB, voffB); PG8_STAGE(PG8_SB(0, 1), cB + hstep, voffB); PG8_STAGE(PG8_SA(0, 0), cA, voffA); PG8_STAGE(PG8_SA(0, 1), cA + hstep, voffA);
        if (wr == 1) PG8_BAR;
        PG8_WAIT_V(2); PG8_BAR;
        PG8_STAGE(PG8_SB(1, 0), cB + kstep, voffB); PG8_STAGE(PG8_SA(1, 0), cA + kstep, voffA); PG8_STAGE(PG8_SB(1, 1), cB + hstep + kstep, voffB);
        PG8_WAIT_V(6); PG8_BAR;
    } else {
        PG8_STAGE(PG8_SB(0, 0), cB, voffB); PG8_STAGE(PG8_SA(0, 0), cA, voffA); PG8_STAGE(PG8_SB(0, 1), cB + hstep, voffB); PG8_STAGE(PG8_SA(0, 1), cA + hstep, voffA);
        if (wr == 1) PG8_BAR;
        PG8_WAIT_V(4); PG8_BAR;
        PG8_STAGE(PG8_SB(1, 0), cB + kstep, voffB); PG8_STAGE(PG8_SA(1, 0), cA + kstep, voffA); PG8_STAGE(PG8_SB(1, 1), cB + hstep + kstep, voffB);
        PG8_WAIT_V(6); PG8_BAR;
    }
    for (;;) {
        const bool has_next = S.next(ui + 1, nxt);
        const char* nA = has_next ? (const char*)g.A + (size_t)nxt.pm * tstep : cA; const char* nB = has_next ? (const char*)g.Bt + (size_t)nxt.pn * tstep : cB;
        for (int t = 0; t < nt; t += 2) {
            const bool last = (t == nt - 2);
            const char* a1 = cA + (size_t)(t + 1) * kstep;
            const char* a2 = last ? nA : cA + (size_t)(t + 2) * kstep; const char* b2 = last ? nB : cB + (size_t)(t + 2) * kstep;
            const char* a3 = a2 + kstep; const char* b3 = b2 + kstep;
            if (last && has_next) S.a_ready(nxt);
            if constexpr (SP2) {
            PG8_LDB(B0, 0, 0); PG8_LDB(B1, 0, 1); PG8_SCHED; PG8_LDA(At, 0, 0); PG8_STAGE(PG8_SA(1, 1), a1 + hstep, voffA);
            PG8_WAIT_V(8); PG8_WAIT_L(0); PG8_BAR; PG8_MMA(0, 0, At, B0); PG8_MMA(0, 1, At, B1); PG8_BAR; PG8_SCHED;
            PG8_LDA(At, 0, 1); PG8_STAGE(PG8_SB(0, 0), b2, voffB); PG8_STAGE(PG8_SB(0, 1), b2 + hstep, voffB); PG8_STAGE(PG8_SA(0, 0), a2, voffA);
            PG8_WAIT_V(8); PG8_WAIT_L(0); PG8_BAR; PG8_MMA(1, 0, At, B0); PG8_MMA(1, 1, At, B1); PG8_BAR; PG8_SCHED;
            PG8_LDB(B0, 1, 0); PG8_LDB(B1, 1, 1); PG8_SCHED; PG8_LDA(At, 1, 0); PG8_STAGE(PG8_SA(0, 1), a2 + hstep, voffA);
            PG8_WAIT_V(8); PG8_WAIT_L(0); PG8_BAR; PG8_MMA(0, 0, At, B0); PG8_MMA(0, 1, At, B1); PG8_BAR; PG8_SCHED;
            PG8_LDA(At, 1, 1); PG8_STAGE(PG8_SB(1, 0), b3, voffB); PG8_STAGE(PG8_SB(1, 1), b3 + hstep, voffB); PG8_STAGE(PG8_SA(1, 0), a3, voffA);
            PG8_WAIT_V(8); PG8_WAIT_L(0); PG8_BAR; PG8_MMA(1, 0, At, B0); PG8_MMA(1, 1, At, B1); PG8_BAR; PG8_SCHED;
            } else {
            PG8_LDB(B0, 0, 0); PG8_SCHED; PG8_LDA(At, 0, 0); PG8_STAGE(PG8_SA(1, 1), a1 + hstep, voffA);
            PG8_WAIT_L(8); PG8_BAR; PG8_WAIT_L(0); PG8_MMA(0, 0, At, B0); PG8_BAR; PG8_SCHED;
            PG8_LDB(B1, 0, 1); PG8_STAGE(PG8_SB(0, 0), b2, voffB);
            PG8_BAR; PG8_WAIT_L(0); PG8_MMA(0, 1, At, B1); PG8_BAR;
            PG8_LDA(At, 0, 1); PG8_STAGE(PG8_SA(0, 0), a2, voffA);
            PG8_BAR; PG8_WAIT_L(0); PG8_MMA(1, 0, At, B0); PG8_BAR; PG8_SCHED;
            PG8_STAGE(PG8_SB(0, 1), b2 + hstep, voffB);
            PG8_WAIT_V(6); PG8_BAR; PG8_MMA(1, 1, At, B1); PG8_BAR;
            PG8_LDB(B0, 1, 0); PG8_SCHED; PG8_LDA(At, 1, 0); PG8_STAGE(PG8_SA(0, 1), a2 + hstep, voffA);
            PG8_WAIT_L(8); PG8_BAR; PG8_WAIT_L(0); PG8_MMA(0, 0, At, B0); PG8_BAR; PG8_SCHED;
            PG8_LDB(B1, 1, 1); PG8_STAGE(PG8_SB(1, 0), b3, voffB);
            PG8_BAR; PG8_WAIT_L(0); PG8_MMA(0, 1, At, B1); PG8_BAR;
            PG8_LDA(At, 1, 1); PG8_STAGE(PG8_SA(1, 0), a3, voffA);
            PG8_BAR; PG8_WAIT_L(0); PG8_MMA(1, 0, At, B0); PG8_BAR; PG8_SCHED;
            PG8_STAGE(PG8_SB(1, 1), b3 + hstep, voffB);
            PG8_WAIT_V(6); PG8_BAR; PG8_MMA(1, 1, At, B1); PG8_BAR;
            }
        }
        if constexpr (ALIGN_EPI) { if (wr == 0) PG8_BAR; }
        if constexpr (!Epi::AFTER_DRAIN) { E(acc, cur, wr, wc, fr, fq); S.done(cur); }
        if (!has_next) break;
#pragma unroll
        for (int a = 0; a < 2; ++a)
#pragma unroll
            for (int b = 0; b < 2; ++b)
#pragma unroll
                for (int m = 0; m < 4; ++m)
#pragma unroll
                    for (int n = 0; n < 2; ++n) acc[a][b][m][n] = (f32x4){0.f, 0.f, 0.f, 0.f};
        cur = nxt; cA = nA; cB = nB; ++ui;
        if constexpr (ALIGN_EPI) { if (wr == 1) PG8_BAR; }
    }
    PG8_WAIT_V(0);
    if constexpr (!ALIGN_EPI) { if (wr == 0) PG8_BAR; }
    PG8_BAR;
    if constexpr (Epi::AFTER_DRAIN) { E.fused(acc, cur, wr, wc, fr, fq, lds, wid, lane); S.done(cur); }
#undef PG8_SA
#undef PG8_SB
#undef PG8_STAGE
#undef PG8_LDA
#undef PG8_LDB
#undef PG8_MMA
#undef PG8_WAIT_V
#undef PG8_WAIT_L
#undef PG8_BAR
#undef PG8_SCHED
}
}

namespace cg = cooperative_groups;
#define GAS __attribute__((address_space(1)))
#define LAS __attribute__((address_space(3)))
typedef unsigned short bf16;
typedef unsigned v4u __attribute__((ext_vector_type(4)));
typedef unsigned v2u __attribute__((ext_vector_type(2)));
typedef float f32x4 __attribute__((ext_vector_type(4)));
typedef float f32x16 __attribute__((ext_vector_type(16)));
typedef short bf16x8 __attribute__((ext_vector_type(8)));
typedef short s16x4 __attribute__((ext_vector_type(4)));
typedef float f32x2_t __attribute__((ext_vector_type(2)));
typedef __bf16 bf16x2_t __attribute__((ext_vector_type(2)));
#define LDS_WAIT() asm volatile("s_waitcnt lgkmcnt(0)" ::: "memory")

#define RLX_AGENT __ATOMIC_RELAXED, __HIP_MEMORY_SCOPE_AGENT
#define XB_TMO      128
#define XB_XCNT(j)  (256  + 64 * (j))
#define XB_XSUB(j)  (1280 + 64 * (j))
#define XB_XGEN(j)  (2304 + 64 * (j))
#define XB_TOP      3328
#define XB_TOPGEN   3392
#define XCD_BAR_WORDS 3456
#define XB_SPIN_CAP (1u << 18)

__device__ __forceinline__ unsigned xb_ld(unsigned* p)              { return __hip_atomic_load(p, __ATOMIC_RELAXED, __HIP_MEMORY_SCOPE_AGENT); }
__device__ __forceinline__ unsigned xb_add(unsigned* p, unsigned v) { return __hip_atomic_fetch_add(p, v, __ATOMIC_RELAXED, __HIP_MEMORY_SCOPE_AGENT); }
__device__ __forceinline__ unsigned xb_xcc_id() { return (unsigned)__builtin_amdgcn_s_getreg((3 << 11) | 20) & 0xFu; }
#define XB_SPIN(cond, bar) do { unsigned _sp = 0; while (cond) { __builtin_amdgcn_s_sleep(1); \
    if ((++_sp & 255u) == 0u) { if (xb_ld(&(bar)[XB_TMO])) break; if (_sp > XB_SPIN_CAP) { atomicAdd(&(bar)[XB_TMO], 1u); break; } } } } while (0)

struct XcdBarrier {
    unsigned* bar; unsigned x;
    volatile LAS unsigned* st;
};

__device__ __forceinline__ XcdBarrier xcd_barrier_post(unsigned* bar, volatile LAS unsigned* st) {
    XcdBarrier b; b.bar = bar; b.x = xb_xcc_id(); b.st = st;
    if (threadIdx.x == 0) (void)xb_add(&bar[XB_XCNT(b.x)], 1u);
    return b;
}
__device__ __forceinline__ void xcd_barrier_complete(unsigned* bar, unsigned x, unsigned& nloc, unsigned& nx) {
    const unsigned G = gridDim.x * gridDim.y * gridDim.z;
    unsigned sum, cnt, mine, sp = 0u;
    for (;;) {
        sum = 0u; cnt = 0u; mine = 0u;
#pragma unroll
        for (unsigned j = 0; j < 16; ++j) { const unsigned c = xb_ld(&bar[XB_XCNT(j)]); sum += c; cnt += (c > 0u) ? 1u : 0u; mine = (j == x) ? c : mine; }
        if (sum == G) break;
        __builtin_amdgcn_s_sleep(1);
        if ((++sp & 255u) == 0u) { if (xb_ld(&bar[XB_TMO])) break; if (sp > XB_SPIN_CAP) { atomicAdd(&bar[XB_TMO], 1u); break; } }
    }
    nloc = mine > 0u ? mine : 1u; nx = cnt > 0u ? cnt : 1u;
}

__device__ __forceinline__ void xcd_barrier(const XcdBarrier& b) {
    asm volatile("s_waitcnt vmcnt(0)" ::: "memory");
    __syncthreads();
    if (threadIdx.x == 0) {
        unsigned* bar = b.bar;
        __builtin_amdgcn_s_waitcnt(0);
        unsigned nloc = b.st[0], nx = b.st[1];
        if (nloc == 0u) { xcd_barrier_complete(bar, b.x, nloc, nx); b.st[0] = nloc; b.st[1] = nx; }
        const unsigned old = xb_add(&bar[XB_XSUB(b.x)], 1u);
        const unsigned gen = old / nloc;
        if (old + 1u == (gen + 1u) * nloc) {
            __builtin_amdgcn_fence(__ATOMIC_RELEASE, "agent");
            asm volatile("s_waitcnt vmcnt(0)" ::: "memory");
            const unsigned og = xb_add(&bar[XB_TOP], 1u);
            const unsigned tg = og / nx;
            if (og + 1u == (tg + 1u) * nx) xb_add(&bar[XB_TOPGEN], 1u);
            else XB_SPIN(xb_ld(&bar[XB_TOPGEN]) == tg, bar);
            __builtin_amdgcn_fence(__ATOMIC_ACQUIRE, "agent");
            xb_add(&bar[XB_XGEN(b.x)], 1u);
            asm volatile("s_waitcnt vmcnt(0)" ::: "memory");
        } else {
            XB_SPIN(xb_ld(&bar[XB_XGEN(b.x)]) == gen, bar);
            __builtin_amdgcn_fence(__ATOMIC_ACQUIRE, "agent");
            asm volatile("s_waitcnt vmcnt(0)" ::: "memory");
        }
    }
    __syncthreads();
}

constexpr int NWAVES = 8;
#ifndef REP_P0
#define REP_P0 1
#endif
#ifndef REP_P1
#define REP_P1 1
#endif
#ifndef REP_P2
#define REP_P2 1
#endif
#ifndef REP_P3
#define REP_P3 1
#endif
#ifndef REP_P4
#define REP_P4 1
#endif
#ifndef REP_PP
#define REP_PP 1
#endif
#ifndef REP_SYNC
#define REP_SYNC 1
#endif
#define GRID_SYNC() do { for (int rs_ = 0; rs_ < REP_SYNC; ++rs_) xcd_barrier(bar); } while (0)
constexpr int BATCH = 4, SEQ = 4096, D = 1024, M = BATCH * SEQ, INC = 3072, FF = 4096, PLE = 256, WCONV = 512, NH = 8, HD = 64;
constexpr int QOFF = 1536, KOFF = 2048, VOFF = 2560;
constexpr float EPS = 1e-6f;
constexpr size_t MiB = 1u << 20;
constexpr size_t WS_CTL = 0, CTL_ZERO_BYTES = 16384;
constexpr size_t WS_SS1 = 1 * MiB, WS_SS2 = 2 * MiB;
constexpr size_t WS_WIN = 4 * MiB, WS_WOUT = 10 * MiB, WS_WUP = 12 * MiB, WS_WDN = 20 * MiB, WS_WG = 28 * MiB, WS_WPP = 30 * MiB;
constexpr size_t WS_PB = 31 * MiB;
constexpr size_t WS_XN = 40 * MiB;
constexpr size_t WS_HB = 72 * MiB;
constexpr size_t WS_PROJ = 104 * MiB;
constexpr size_t WS_END = 232 * MiB;

__device__ __forceinline__ unsigned f2bf(float f) { unsigned u = __builtin_bit_cast(unsigned, f); return (u + 0x7fffu + ((u >> 16) & 1u)) >> 16; }
__device__ __forceinline__ unsigned pk2(float lo, float hi) { f32x2_t v = {lo, hi}; bf16x2_t b = __builtin_convertvector(v, bf16x2_t); return __builtin_bit_cast(unsigned, b); }
__device__ __forceinline__ float bflo(unsigned w) { return __uint_as_float(w << 16); }
__device__ __forceinline__ float bfhi(unsigned w) { return __uint_as_float(w & 0xffff0000u); }
__device__ __forceinline__ float wave_sum(float v) {
#pragma unroll
    for (int o = 1; o < 64; o <<= 1) v += __shfl_xor(v, o);
    return v;
}
__device__ __forceinline__ void p0_transpose_item(const float* W, const float* g, int K, int N, bf16* WT, LAS float* scr, int item, int lane) {
    const int nblk = N / 32, kb = item / nblk, nb = item % nblk, k0 = 64 * kb, n0 = 32 * nb;
#pragma unroll 8
    for (int i = 0; i < 32; ++i) { const int kk = 2 * i + (lane >> 5); const float gv = g ? g[k0 + kk] : 1.0f; scr[kk * 33 + (lane & 31)] = W[(size_t)(k0 + kk) * N + n0 + (lane & 31)] * gv; }
    LDS_WAIT(); asm volatile("" ::: "memory");
    const int c = lane & 7;
#pragma unroll
    for (int j = 0; j < 4; ++j) { const int n = (lane >> 3) + 8 * j; const LAS float* s = scr + (8 * c) * 33 + n;
        v4u o; o.x = pk2(s[0 * 33], s[1 * 33]); o.y = pk2(s[2 * 33], s[3 * 33]); o.z = pk2(s[4 * 33], s[5 * 33]); o.w = pk2(s[6 * 33], s[7 * 33]);
        *(GAS v4u*)(WT + (size_t)(n0 + n) * K + k0 + 8 * c) = o; }
    LDS_WAIT(); asm volatile("" ::: "memory");
}
__device__ __forceinline__ void rms_row_to_bf16(const float* xrow, const float* g, bf16* orow, int lane) {
    const GAS f32x4* xr = (const GAS f32x4*)xrow + lane; const GAS f32x4* gr = (const GAS f32x4*)g + lane;
    f32x4 v[4]; float s = 0.f;
#pragma unroll
    for (int j = 0; j < 4; ++j) { v[j] = xr[64 * j]; s += (v[j].x * v[j].x + v[j].y * v[j].y) + (v[j].z * v[j].z + v[j].w * v[j].w); }
    const float rs = 1.f / sqrtf(wave_sum(s) * (1.f / D) + EPS);
    GAS v2u* o8 = (GAS v2u*)orow + lane;
#pragma unroll
    for (int j = 0; j < 4; ++j) { const f32x4 gg = gr[64 * j]; v2u w; w.x = pk2(v[j].x * rs * gg.x, v[j].y * rs * gg.y); w.y = pk2(v[j].z * rs * gg.z, v[j].w * rs * gg.w); o8[64 * j] = w; }
}
__device__ __forceinline__ void rms_row_final(float* xrow, const float* g, int lane) {
    GAS f32x4* xr = (GAS f32x4*)xrow + lane; const GAS f32x4* gr = (const GAS f32x4*)g + lane;
    f32x4 v[4]; float s = 0.f;
#pragma unroll
    for (int j = 0; j < 4; ++j) { v[j] = xr[64 * j]; s += (v[j].x * v[j].x + v[j].y * v[j].y) + (v[j].z * v[j].z + v[j].w * v[j].w); }
    const float rs = 1.f / sqrtf(wave_sum(s) * (1.f / D) + EPS);
#pragma unroll
    for (int j = 0; j < 4; ++j) { const f32x4 gg = gr[64 * j]; xr[64 * j] = v[j] * rs * gg; }
}

__device__ __forceinline__ void unpack8(const v4u w, float (&f)[8]) { f[0] = bflo(w.x); f[1] = bfhi(w.x); f[2] = bflo(w.y); f[3] = bfhi(w.y); f[4] = bflo(w.z); f[5] = bfhi(w.z); f[6] = bflo(w.w); f[7] = bfhi(w.w); }
__device__ __forceinline__ void conv_chunk(const bf16* PROJ, bf16* MIX, const float* cw, const float* gco, int row0, int lane) {
    const int c0 = lane * 8;
    float w0[8], w1[8], w2[8], gg[8];
#pragma unroll
    for (int j = 0; j < 8; ++j) { w0[j] = cw[c0 + j]; w1[j] = cw[WCONV + c0 + j]; w2[j] = cw[2 * WCONV + c0 + j]; gg[j] = gco[c0 + j]; }
    float vm2[8], vm1[8];
#pragma unroll
    for (int j = 0; j < 8; ++j) { vm2[j] = 0.f; vm1[j] = 0.f; }
    if ((row0 & (SEQ - 1)) != 0) {
        float a[8], b[8];
        const bf16* p2 = PROJ + (size_t)(row0 - 2) * INC + c0; const bf16* p1 = PROJ + (size_t)(row0 - 1) * INC + c0;
        unpack8(*(const GAS v4u*)(p2 + 512), a); unpack8(*(const GAS v4u*)(p2 + 1024), b);
#pragma unroll
        for (int j = 0; j < 8; ++j) vm2[j] = a[j] * b[j];
        unpack8(*(const GAS v4u*)(p1 + 512), a); unpack8(*(const GAS v4u*)(p1 + 1024), b);
#pragma unroll
        for (int j = 0; j < 8; ++j) vm1[j] = a[j] * b[j];
    }
#pragma unroll 2
    for (int i = 0; i < 8; ++i) {
        const bf16* pr = PROJ + (size_t)(row0 + i) * INC + c0;
        float cb[8], cc[8], cu[8], y[8];
        unpack8(*(const GAS v4u*)(pr), cb); unpack8(*(const GAS v4u*)(pr + 512), cc); unpack8(*(const GAS v4u*)(pr + 1024), cu);
        float ss = 0.f;
#pragma unroll
        for (int j = 0; j < 8; ++j) { const float v = cc[j] * cu[j]; y[j] = cb[j] * (w0[j] * vm2[j] + w1[j] * vm1[j] + w2[j] * v); ss += y[j] * y[j]; vm2[j] = vm1[j]; vm1[j] = v; }
        ss += __shfl_xor(ss, 1); ss += __shfl_xor(ss, 2); ss += __shfl_xor(ss, 4);
        const float rs = 1.f / sqrtf(ss * (1.f / HD) + EPS);
        v4u o; o.x = pk2(y[0] * rs * gg[0], y[1] * rs * gg[1]); o.y = pk2(y[2] * rs * gg[2], y[3] * rs * gg[3]); o.z = pk2(y[4] * rs * gg[4], y[5] * rs * gg[5]); o.w = pk2(y[6] * rs * gg[6], y[7] * rs * gg[7]);
        *(GAS v4u*)(MIX + (size_t)(row0 + i) * D + c0) = o;
    }
}

__device__ __forceinline__ int crow(int r, int hi) { return (r & 3) + 8 * (r >> 2) + 4 * hi; }
constexpr int VPITCH = 144;
__device__ __forceinline__ void sb_unit(const bf16* PROJ, bf16* MIX, const float* gattn, int b, int h, int qt, LAS unsigned char* vl, int lane) {
    const int r = lane & 31, hh = lane >> 5;
    const size_t rowbase = (size_t)b * SEQ;
    const bf16* qp = PROJ + (rowbase + qt * 32 + r) * INC + QOFF + h * HD + 8 * hh;
    bf16x8 qf[4];
#pragma unroll
    for (int d0 = 0; d0 < 4; ++d0) qf[d0] = *(const GAS bf16x8*)(qp + d0 * 16);
    f32x16 o0, o1;
#pragma unroll
    for (int i = 0; i < 16; ++i) { o0[i] = 0.f; o1[i] = 0.f; }
    float R = 0.f;
    const float SC = 0.125f * 1.4426950408889634f;
    const bf16* kbase = PROJ + (rowbase + r) * INC + KOFF + h * HD + 8 * hh;
    const bf16* vbase = PROJ + (rowbase + (lane >> 3)) * INC + VOFF + h * HD + (lane & 7) * 8;
    bf16x8 kf[4]; v4u vv[4];
#define SB_LOADT(t) do { const bf16* kp_ = kbase + (size_t)(t) * 32 * INC; const bf16* vp_ = vbase + (size_t)(t) * 32 * INC; \
        _Pragma("unroll") for (int d0 = 0; d0 < 4; ++d0) kf[d0] = *(const GAS bf16x8*)(kp_ + d0 * 16); \
        _Pragma("unroll") for (int i = 0; i < 4; ++i) vv[i] = *(const GAS v4u*)(vp_ + (size_t)(8 * i) * INC); } while (0)
    SB_LOADT(qt);
    const int i16 = lane & 15, q4 = i16 >> 2, p4 = i16 & 3, blk = (lane >> 4) & 1;
    LAS unsigned char* vrd = vl + (4 * hh + q4) * VPITCH + blk * 32 + p4 * 8;
    LAS unsigned char* vwr = vl + (lane >> 3) * VPITCH + (lane & 7) * 16;
    for (int kt = qt; kt >= 0; --kt) {
        bf16x8 kc[4]; v4u vc[4];
#pragma unroll
        for (int i = 0; i < 4; ++i) { kc[i] = kf[i]; vc[i] = vv[i]; }
        if (kt > 0) SB_LOADT(kt - 1);
#pragma unroll
        for (int i = 0; i < 4; ++i) *(LAS v4u*)(vwr + 8 * i * VPITCH) = vc[i];
        f32x16 s;
#pragma unroll
        for (int i = 0; i < 16; ++i) s[i] = 0.f;
#pragma unroll
        for (int d0 = 0; d0 < 4; ++d0) s = __builtin_amdgcn_mfma_f32_32x32x16_bf16(kc[d0], qf[d0], s, 0, 0, 0);
        float z2[16], lk[16], p[16];
        const bool diag = (kt == qt);
#pragma unroll
        for (int i = 0; i < 16; ++i) { z2[i] = s[i] * SC; const float e = __builtin_amdgcn_exp2f(-fabsf(z2[i])); const float l = __builtin_amdgcn_logf(1.0f + e); lk[i] = -(fmaxf(z2[i], 0.f) + l); }
        if (diag) {
#pragma unroll
            for (int i = 0; i < 16; ++i) if (crow(i, hh) >= r) lk[i] = 0.f;
        }
        float g[4], og[4], tot[4], T[4];
#pragma unroll
        for (int a = 0; a < 4; ++a) { g[a] = (lk[4 * a] + lk[4 * a + 1]) + (lk[4 * a + 2] + lk[4 * a + 3]); og[a] = __shfl_xor(g[a], 32); tot[a] = g[a] + og[a]; }
        T[3] = R; T[2] = T[3] + tot[3]; T[1] = T[2] + tot[2]; T[0] = T[1] + tot[1];
        const float Rn = T[0] + tot[0];
        if (hh == 0) {
#pragma unroll
            for (int a = 0; a < 4; ++a) T[a] += og[a];
        }
#pragma unroll
        for (int a = 0; a < 4; ++a) { const float c3 = T[a], c2 = c3 + lk[4 * a + 3], c1 = c2 + lk[4 * a + 2], c0 = c1 + lk[4 * a + 1];
            p[4 * a + 3] = __builtin_amdgcn_exp2f(z2[4 * a + 3] + lk[4 * a + 3] + c3); p[4 * a + 2] = __builtin_amdgcn_exp2f(z2[4 * a + 2] + lk[4 * a + 2] + c2);
            p[4 * a + 1] = __builtin_amdgcn_exp2f(z2[4 * a + 1] + lk[4 * a + 1] + c1); p[4 * a] = __builtin_amdgcn_exp2f(z2[4 * a] + lk[4 * a] + c0); }
        if (diag) {
#pragma unroll
            for (int i = 0; i < 16; ++i) if (crow(i, hh) >= r) p[i] = 0.f;
        }
        R = Rn;
        v4u pw0, pw1;
        pw0.x = pk2(p[0], p[1]); pw0.y = pk2(p[2], p[3]); pw0.z = pk2(p[4], p[5]); pw0.w = pk2(p[6], p[7]);
        pw1.x = pk2(p[8], p[9]); pw1.y = pk2(p[10], p[11]); pw1.z = pk2(p[12], p[13]); pw1.w = pk2(p[14], p[15]);
        const bf16x8 pf0 = __builtin_bit_cast(bf16x8, pw0), pf1 = __builtin_bit_cast(bf16x8, pw1);
        asm volatile("" ::: "memory");
#define SB_VTR(off) __builtin_bit_cast(s16x4, __builtin_amdgcn_ds_read_tr16_b64_v4i16((LAS s16x4*)(vrd + (off))))
#pragma unroll
        for (int sk = 0; sk < 2; ++sk) {
            const s16x4 l0 = SB_VTR(16 * sk * VPITCH), h0 = SB_VTR((16 * sk + 8) * VPITCH), l1 = SB_VTR(16 * sk * VPITCH + 64), h1 = SB_VTR((16 * sk + 8) * VPITCH + 64);
            const bf16x8 v0 = __builtin_shufflevector(l0, h0, 0, 1, 2, 3, 4, 5, 6, 7), v1 = __builtin_shufflevector(l1, h1, 0, 1, 2, 3, 4, 5, 6, 7);
            o0 = __builtin_amdgcn_mfma_f32_32x32x16_bf16(v0, sk ? pf1 : pf0, o0, 0, 0, 0);
            o1 = __builtin_amdgcn_mfma_f32_32x32x16_bf16(v1, sk ? pf1 : pf0, o1, 0, 0, 0);
        }
        asm volatile("" ::: "memory");
        if (__all(R < -150.0f)) break;
    }
#undef SB_VTR
#undef SB_LOADT
    float ss = 0.f;
#pragma unroll
    for (int i = 0; i < 16; ++i) ss += o0[i] * o0[i] + o1[i] * o1[i];
    ss += __shfl_xor(ss, 32);
    const float rs = 1.f / sqrtf(ss * (1.f / HD) + EPS);
    bf16* op = MIX + (rowbase + qt * 32 + r) * D + WCONV + h * HD + 4 * hh;
    const float* gp = gattn + h * HD + 4 * hh;
#pragma unroll
    for (int a = 0; a < 4; ++a) {
        const f32x4 g0 = *(const GAS f32x4*)(gp + 8 * a), g1 = *(const GAS f32x4*)(gp + 32 + 8 * a);
        v2u w0, w1;
        w0.x = pk2(o0[4 * a] * rs * g0.x, o0[4 * a + 1] * rs * g0.y); w0.y = pk2(o0[4 * a + 2] * rs * g0.z, o0[4 * a + 3] * rs * g0.w);
        w1.x = pk2(o1[4 * a] * rs * g1.x, o1[4 * a + 1] * rs * g1.y); w1.y = pk2(o1[4 * a + 2] * rs * g1.z, o1[4 * a + 3] * rs * g1.w);
        *(GAS v2u*)(op + 8 * a) = w0; *(GAS v2u*)(op + 32 + 8 * a) = w1;
    }
}

constexpr int LDS_BYTES = 147456;
struct Args { const float* in[15]; float* out; unsigned char* ws; };
__global__ void __launch_bounds__(NWAVES * 64, 2) hymba_fwd(Args args) {
    extern __shared__ __attribute__((aligned(16))) unsigned char lds_raw[];
    cg::grid_group grid = cg::this_grid();
    LAS unsigned char* lds = (LAS unsigned char*)lds_raw;
    const int tid = threadIdx.x, lane = tid & 63, wave = __builtin_amdgcn_readfirstlane(tid >> 6);
    const int G = gridDim.x; const int bx = blockIdx.x; const int vcu = (G % 8 == 0) ? (bx % 8) * (G / 8) + bx / 8 : bx;
    const int gw = vcu * NWAVES + wave, NGW = G * NWAVES;
    const float* x = args.in[0]; const float* pin = args.in[1]; const float* g_mix = args.in[2]; const float* w_in = args.in[3]; const float* conv_w = args.in[4];
    const float* g_conv = args.in[5]; const float* g_attn = args.in[6]; const float* w_out = args.in[7]; const float* g_mlp = args.in[8]; const float* w_up = args.in[9];
    const float* w_down = args.in[10]; const float* g_ple = args.in[11]; const float* w_gate = args.in[12]; const float* w_pp = args.in[13]; const float* g_final = args.in[14];
    float* out = args.out; unsigned char* ws = args.ws;
    volatile LAS unsigned* bst = (volatile LAS unsigned*)(lds + 131072);
    if (tid == 0) { bst[0] = 0u; bst[1] = 0u; }
    __syncthreads();
    const XcdBarrier bar = xcd_barrier_post((unsigned*)(ws + WS_CTL), bst);
    grid.sync();
    float* SS1 = (float*)(ws + WS_SS1); float* SS2 = (float*)(ws + WS_SS2);
    bf16* WIN = (bf16*)(ws + WS_WIN); bf16* WOUT = (bf16*)(ws + WS_WOUT); bf16* WUP = (bf16*)(ws + WS_WUP); bf16* WDN = (bf16*)(ws + WS_WDN); bf16* WG = (bf16*)(ws + WS_WG); bf16* WPP = (bf16*)(ws + WS_WPP);
    bf16* PB = (bf16*)(ws + WS_PB); bf16* XN = (bf16*)(ws + WS_XN); bf16* HB = (bf16*)(ws + WS_HB); bf16* PROJ = (bf16*)(ws + WS_PROJ);
    bf16* MIX = XN; bf16* PP = XN; bf16* U = PROJ;

    for (int rep_ = 0; rep_ < REP_P0; ++rep_) {
        LAS float* scr = (LAS float*)(lds + wave * 16384);
        constexpr int I_IN = (D / 64) * (INC / 32), I_OUT = (D / 64) * (D / 32), I_UP = (D / 64) * (FF / 32), I_DN = (FF / 64) * (D / 32), I_G = I_OUT, I_PP = (PLE / 64) * (D / 32);
        constexpr int NITEMS = I_IN + I_OUT + I_UP + I_DN + I_G + I_PP;
        for (int it = gw; it < NITEMS; it += NGW) {
            int r = it;
            if (r < I_IN) { p0_transpose_item(w_in, nullptr, D, INC, WIN, scr, r, lane); continue; } r -= I_IN;
            if (r < I_OUT) { p0_transpose_item(w_out, nullptr, D, D, WOUT, scr, r, lane); continue; } r -= I_OUT;
            if (r < I_UP) { p0_transpose_item(w_up, g_mlp, D, FF, WUP, scr, r, lane); continue; } r -= I_UP;
            if (r < I_DN) { p0_transpose_item(w_down, nullptr, FF, D, WDN, scr, r, lane); continue; } r -= I_DN;
            if (r < I_G) { p0_transpose_item(w_gate, g_ple, D, D, WG, scr, r, lane); continue; } r -= I_G;
            p0_transpose_item(w_pp, nullptr, PLE, D, WPP, scr, r, lane);
        }
        for (int m = gw; m < M; m += NGW) rms_row_to_bf16(x + (size_t)m * D, g_mix, XN + (size_t)m * D, lane);
        for (int i = gw * 64 + lane; i < M * PLE / 8; i += NGW * 64) {
            const f32x4 a = *(const GAS f32x4*)(pin + (size_t)i * 8), b = *(const GAS f32x4*)(pin + (size_t)i * 8 + 4);
            v4u o; o.x = pk2(a.x, a.y); o.y = pk2(a.z, a.w); o.z = pk2(b.x, b.y); o.w = pk2(b.z, b.w);
            *(GAS v4u*)(PB + (size_t)i * 8) = o;
        }
    }
    GRID_SYNC();
    for (int rep_ = 0; rep_ < REP_P1; ++rep_) {
        pg8::Gemm g{XN, WIN, M, INC, D}; pg8::StaticOrder S; S.init(M, INC, G, bx);
        pg8::EpiBf16 E{PROJ, INC};
        pg8::gemm_phase<pg8::EpiBf16, pg8::StaticOrder, true, true>(lds, g, S, E);
    }
    GRID_SYNC();
    for (int rep_ = 0; rep_ < REP_P2; ++rep_) {
        for (int c = gw; c < M / 8; c += NGW) conv_chunk(PROJ, MIX, conv_w, g_conv, c * 8, lane);
        LAS unsigned char* vl = lds + wave * 8192;
        for (int u = gw; u < BATCH * NH * (SEQ / 32); u += NGW) { const int bh = u / (SEQ / 32), qt = u % (SEQ / 32); sb_unit(PROJ, MIX, g_attn, bh / NH, bh % NH, qt, vl, lane); }
    }
    GRID_SYNC();
    for (int rep_ = 0; rep_ < REP_P3; ++rep_) {
        pg8::Gemm g{MIX, WOUT, M, D, D}; pg8::StaticOrder S; S.init(M, D, G, bx);
        pg8::EpiRes E{x, out, HB, D, SS1, M};
        pg8::gemm_phase<pg8::EpiRes, pg8::StaticOrder, true, true>(lds, g, S, E);
    }
    GRID_SYNC();
    for (int rep_ = 0; rep_ < REP_P4; ++rep_) {
        pg8::Gemm g{HB, WUP, M, FF, D}; pg8::StaticOrder S; S.init(M, FF, G, bx);
        pg8::EpiUp E{U, FF, SS1, M, EPS};
        pg8::gemm_phase<pg8::EpiUp, pg8::StaticOrder, true, true>(lds, g, S, E);
    }
    GRID_SYNC();
    {
        pg8::Gemm g{U, WDN, M, D, FF}; pg8::StaticOrder S; S.init(M, D, G, bx);
        pg8::EpiRes E{out, out, HB, D, SS2, M};
        pg8::gemm_phase<pg8::EpiRes, pg8::StaticOrder, true, true>(lds, g, S, E);
    }
    for (int rep_ = 0; rep_ < REP_PP; ++rep_) {
        pg8::Gemm g{PB, WPP, M, D, PLE}; pg8::StaticOrder S; S.init(M, D, G, bx);
        pg8::EpiBf16 E{PP, D};
        pg8::gemm_phase<pg8::EpiBf16, pg8::StaticOrder, true, true>(lds, g, S, E);
    }
    GRID_SYNC();
    {
        pg8::Gemm g{HB, WG, M, D, D}; pg8::StaticOrder S; S.init(M, D, G, bx);
        pg8::EpiGate E{out, out, PP, D, SS2, M, EPS};
        pg8::gemm_phase<pg8::EpiGate, pg8::StaticOrder, true, true>(lds, g, S, E);
    }
    GRID_SYNC();
    for (int m = gw; m < M; m += NGW) rms_row_final(out + (size_t)m * D, g_final, lane);
}

extern "C" void kernel_launch(void* const* d_in, const int* in_sizes, int n_in, void* d_out, int out_size, void* d_ws, size_t ws_size, hipStream_t stream) {
    static int grid = 0;
    if (grid == 0) {
        if (n_in != 15 || in_sizes[0] != M * D || out_size != M * D || ws_size < WS_END) { fprintf(stderr, "kernel_launch: unexpected shapes (n_in %d, in0 %d, out %d, ws %zu); nothing launched\n", n_in, n_in > 0 ? in_sizes[0] : -1, out_size, ws_size); grid = -1; return; }
        int dev = 0, cus = 0, per_cu = 0;
        if (hipGetDevice(&dev) != hipSuccess || hipDeviceGetAttribute(&cus, hipDeviceAttributeMultiprocessorCount, dev) != hipSuccess) { fprintf(stderr, "kernel_launch: device query failed\n"); grid = -1; return; }
        if (hipFuncSetAttribute((const void*)hymba_fwd, hipFuncAttributeMaxDynamicSharedMemorySize, LDS_BYTES) != hipSuccess) { fprintf(stderr, "kernel_launch: hipFuncSetAttribute failed\n"); grid = -1; return; }
        if (hipOccupancyMaxActiveBlocksPerMultiprocessor(&per_cu, (const void*)hymba_fwd, NWAVES * 64, LDS_BYTES) != hipSuccess || per_cu < 1) { fprintf(stderr, "kernel_launch: occupancy query gave %d\n", per_cu); per_cu = 1; }
        (void)hipGetLastError();
        grid = cus * per_cu;
    }
    if (grid < 0) return;
    if (hipMemsetAsync((char*)d_ws + WS_CTL, 0, CTL_ZERO_BYTES, stream) != hipSuccess) { fprintf(stderr, "kernel_launch: memset of the barrier words failed\n"); return; }
    Args a{};
    for (int i = 0; i < 15; ++i) a.in[i] = (const float*)d_in[i];
    a.out = (float*)d_out; a.ws = (unsigned char*)d_ws;
    void* kargs[] = {&a};
    const hipError_t e = hipLaunchCooperativeKernel((const void*)hymba_fwd, dim3(grid), dim3(NWAVES * 64), kargs, LDS_BYTES, stream);
    if (e != hipSuccess) fprintf(stderr, "kernel_launch: cooperative launch failed: %s (grid %d)\n", hipGetErrorString(e), grid);
}
```

```cpp
#include <hip/hip_runtime.h>
#include <hip/hip_cooperative_groups.h>
#include <cstdio>
#include <cstdint>
namespace pg8 {
#define PG8_LAS __attribute__((address_space(3)))
typedef unsigned short bf16_t;
typedef short bf16x8 __attribute__((ext_vector_type(8)));
typedef float f32x4 __attribute__((ext_vector_type(4)));
typedef unsigned u32x4 __attribute__((ext_vector_type(4)));
constexpr int BM = 256, BK = 64, HALF = 128, HTB = HALF * BK * 2  , STAGE_BYTES = 8 * HTB, NXCD = 8, WGM = 8;

__host__ __device__ __forceinline__ int lds_byte(int r, int c) { const int st = (r >> 4) * 2 + (c >> 5), rr = r & 15, cc = c & 31, ob = rr * 64 + cc * 2; return st * 1024 + (ob ^ (((ob >> 9) & 1) << 5)); }
__host__ __device__ __forceinline__ void stage_rc(int b, int& R, int& C) { const int st = b / 1024, sb = b % 1024, swz = sb ^ (((sb >> 9) & 1) << 5); R = (st >> 1) * 16 + swz / 64; C = (st & 1) * 32 + (swz % 64) / 2; }
__host__ __device__ __forceinline__ int perm32(int rho) { const int n = rho >> 4, i = rho & 15; return 8 * (i >> 2) + 4 * n + (i & 3); }

struct Unit { int pm, pn; };
struct Gemm { const bf16_t* A; const bf16_t* Bt; int M, N, K; };

struct StaticOrder {
    int nM, nN, nwg, G, c;
    __host__ __device__ void init(int M, int N, int G_, int c_) { nM = M / BM; nN = N / BM; nwg = nM * nN; G = G_; c = c_; }
    __host__ __device__ bool next(int i, Unit& u) const {
        const long L = (long)i * G + c; if (L >= nwg) return false;
        int wgid = (int)L; { const int q = nwg / NXCD, r = nwg % NXCD, xcd = wgid % NXCD, off = wgid / NXCD; wgid = (xcd < r ? xcd * (q + 1) : r * (q + 1) + (xcd - r) * q) + off; }
        const int nig = WGM * nN, gid = wgid / nig, fm = gid * WGM, gsz = (nM - fm) < WGM ? (nM - fm) : WGM;
        u.pm = fm + ((wgid % nig) % gsz); u.pn = (wgid % nig) / gsz; return true;
    }
    __device__ __forceinline__ void a_ready(const Unit&) const {}
    __device__ __forceinline__ void done(const Unit&) const {}
};

__device__ __forceinline__ unsigned cvt_pk_bf16(float lo, float hi) { unsigned r; asm volatile("v_cvt_pk_bf16_f32 %0, %1, %2" : "=v"(r) : "v"(lo), "v"(hi)); return r; }
typedef float f32x2 __attribute__((ext_vector_type(2)));
typedef unsigned u32x2 __attribute__((ext_vector_type(2)));
constexpr int NSS = 16;
__device__ __forceinline__ float row_rs(const float* ss, int M, int row, float eps) {
    float s = 0.f;
#pragma unroll
    for (int t = 0; t < NSS; ++t) s += ss[(size_t)t * M + row];
    return 1.0f / sqrtf(s * (1.0f / 1024.0f) + eps);
}
struct EpiBf16 {
    static constexpr bool PERM = true, AFTER_DRAIN = false;
    bf16_t* O; int ldc;
    __device__ __forceinline__ void operator()(const f32x4 (&acc)[2][2][4][2], const Unit& u, int wr, int wc, int fr, int fq) const {
        const int row0 = u.pm * BM + wr * 64 + fr, col0 = u.pn * BM + wc * 32 + 8 * fq;
#pragma unroll
        for (int ai = 0; ai < 2; ++ai)
#pragma unroll
            for (int m = 0; m < 4; ++m) { bf16_t* rowp = O + (size_t)(row0 + ai * HALF + m * 16) * ldc + col0;
#pragma unroll
                for (int bj = 0; bj < 2; ++bj) { const f32x4 v0 = acc[ai][bj][m][0], v1 = acc[ai][bj][m][1];
                    u32x4 w; w.x = cvt_pk_bf16(v0[0], v0[1]); w.y = cvt_pk_bf16(v0[2], v0[3]); w.z = cvt_pk_bf16(v1[0], v1[1]); w.w = cvt_pk_bf16(v1[2], v1[3]);
                    *(u32x4*)(rowp + bj * HALF) = w; } }
    }
};
template <bool SQ> __device__ __forceinline__ void rows_rs(const float* ss, int M, int rowb, int fq, float eps, float (&rs)[2][4]) {
    float p[2][4][4];
#pragma unroll
    for (int ai = 0; ai < 2; ++ai)
#pragma unroll
        for (int m = 0; m < 4; ++m)
#pragma unroll
            for (int t = 0; t < 4; ++t) p[ai][m][t] = ss[(size_t)(4 * fq + t) * M + rowb + ai * HALF + m * 16];
#pragma unroll
    for (int ai = 0; ai < 2; ++ai)
#pragma unroll
        for (int m = 0; m < 4; ++m) { float q = (p[ai][m][0] + p[ai][m][1]) + (p[ai][m][2] + p[ai][m][3]); q += __shfl_xor(q, 16); q += __shfl_xor(q, 32);
            const float v = q * (1.0f / 1024.0f) + eps; rs[ai][m] = SQ ? 1.0f / v : 1.0f / sqrtf(v); }
}
struct EpiUp {
    static constexpr bool PERM = true, AFTER_DRAIN = false;
    bf16_t* O; int ldc;
    __device__ __forceinline__ void operator()(const f32x4 (&acc)[2][2][4][2], const Unit& u, int wr, int wc, int fr, int fq) const {
        const int row0 = u.pm * BM + wr * 64 + fr, col0 = u.pn * BM + wc * 32 + 8 * fq;
#pragma unroll
        for (int ai = 0; ai < 2; ++ai)
#pragma unroll
            for (int m = 0; m < 4; ++m) { bf16_t* rowp = O + (size_t)(row0 + ai * HALF + m * 16) * ldc + col0;
#pragma unroll
                for (int bj = 0; bj < 2; ++bj) { f32x4 v0 = acc[ai][bj][m][0], v1 = acc[ai][bj][m][1];
#pragma unroll
                    for (int e = 0; e < 4; ++e) { const float a = fmaxf(v0[e], 0.f), b = fmaxf(v1[e], 0.f); v0[e] = a * a; v1[e] = b * b; }
                    u32x4 w; w.x = cvt_pk_bf16(v0[0], v0[1]); w.y = cvt_pk_bf16(v0[2], v0[3]); w.z = cvt_pk_bf16(v1[0], v1[1]); w.w = cvt_pk_bf16(v1[2], v1[3]);
                    *(u32x4*)(rowp + bj * HALF) = w; } }
    }
};
template <bool BASE_F32, bool SCALE> struct EpiRes {
    static constexpr bool PERM = false, AFTER_DRAIN = false;
    const float* base; const bf16_t* basb; bf16_t* outb; int ldc; const float* ssin; float* ss; int M; float eps;
    __device__ __forceinline__ void operator()(const f32x4 (&acc)[2][2][4][2], const Unit& u, int wr, int wc, int fr, int fq) const {
        const int col0 = u.pn * BM + wc * 32 + 4 * fq, rowb = u.pm * BM + wr * 64 + fr;
        float rs2[2][4];
        if (SCALE) rows_rs<true>(ssin, M, rowb, fq, eps, rs2);
#pragma unroll
        for (int ai = 0; ai < 2; ++ai)
#pragma unroll
            for (int m = 0; m < 4; ++m) { const int row = rowb + ai * HALF + m * 16; const size_t off = (size_t)row * ldc + col0; float q = 0.f;
#pragma unroll
                for (int bj = 0; bj < 2; ++bj)
#pragma unroll
                    for (int n = 0; n < 2; ++n) { f32x4 bs;
                        if (BASE_F32) bs = *(const f32x4*)(base + off + bj * HALF + n * 16);
                        else { const u32x2 bw = *(const u32x2*)(basb + off + bj * HALF + n * 16); bs[0] = __uint_as_float(bw.x << 16); bs[1] = __uint_as_float(bw.x & 0xffff0000u); bs[2] = __uint_as_float(bw.y << 16); bs[3] = __uint_as_float(bw.y & 0xffff0000u); }
                        const f32x4 o = SCALE ? bs + acc[ai][bj][m][n] * rs2[ai][m] : bs + acc[ai][bj][m][n];
                        u32x2 w; w.x = cvt_pk_bf16(o[0], o[1]); w.y = cvt_pk_bf16(o[2], o[3]); *(u32x2*)(outb + off + bj * HALF + n * 16) = w;
                        q += (o[0] * o[0] + o[1] * o[1]) + (o[2] * o[2] + o[3] * o[3]); }
                q += __shfl_xor(q, 16); q += __shfl_xor(q, 32);
                if (fq == 0) ss[(size_t)(u.pn * 4 + wc) * M + row] = q;
                if (m & 1) asm volatile("" ::: "memory"); }
    }
};
struct EpiGate {
    static constexpr bool PERM = false, AFTER_DRAIN = false;
    const bf16_t* basb; bf16_t* outb; const bf16_t* pp; int ldc; const float* ssin; int M; float eps;
    __device__ __forceinline__ void operator()(const f32x4 (&acc)[2][2][4][2], const Unit& u, int wr, int wc, int fr, int fq) const {
        const int col0 = u.pn * BM + wc * 32 + 4 * fq, rowb = u.pm * BM + wr * 64 + fr;
        float rs[2][4];
        rows_rs<false>(ssin, M, rowb, fq, eps, rs);
#pragma unroll
        for (int ai = 0; ai < 2; ++ai)
#pragma unroll
            for (int m = 0; m < 4; ++m) { const int row = rowb + ai * HALF + m * 16; const size_t off = (size_t)row * ldc + col0;
#pragma unroll
                for (int bj = 0; bj < 2; ++bj)
#pragma unroll
                    for (int n = 0; n < 2; ++n) { const u32x2 bw = *(const u32x2*)(basb + off + bj * HALF + n * 16); const u32x2 pw = *(const u32x2*)(pp + off + bj * HALF + n * 16);
                        const f32x4 a = acc[ai][bj][m][n] * rs[ai][m];
                        f32x4 bs, pv; bs[0] = __uint_as_float(bw.x << 16); bs[1] = __uint_as_float(bw.x & 0xffff0000u); bs[2] = __uint_as_float(bw.y << 16); bs[3] = __uint_as_float(bw.y & 0xffff0000u);
                        pv[0] = __uint_as_float(pw.x << 16); pv[1] = __uint_as_float(pw.x & 0xffff0000u); pv[2] = __uint_as_float(pw.y << 16); pv[3] = __uint_as_float(pw.y & 0xffff0000u);
                        f32x4 o;
#pragma unroll
                        for (int e = 0; e < 4; ++e) { const float sg = __builtin_amdgcn_rcpf(1.0f + __expf(-a[e])); o[e] = bs[e] + sg * pv[e]; }
                        u32x2 w; w.x = cvt_pk_bf16(o[0], o[1]); w.y = cvt_pk_bf16(o[2], o[3]); *(u32x2*)(outb + off + bj * HALF + n * 16) = w; }
                if (m & 1) asm volatile("" ::: "memory"); }
    }
};

template <class Epi, class Sched, bool ALIGN_EPI = false, bool SP2 = false>
__device__ __forceinline__ void gemm_phase(PG8_LAS unsigned char* lds, const Gemm g, const Sched& S, const Epi& E) {
    const int tid = threadIdx.x, wid = __builtin_amdgcn_readfirstlane(tid >> 6), lane = tid & 63, wr = wid >> 2, wc = wid & 3, fr = lane & 15, fq = lane >> 4;
    const int K = g.K, nt = K / BK;
    unsigned voffA[2], voffB[2];
#pragma unroll
    for (int i = 0; i < 2; ++i) { int R, C; stage_rc(tid * 16 + i * 8192, R, C); const int Rb = Epi::PERM ? ((R & ~31) + perm32(R & 31)) : R;
        voffA[i] = (unsigned)(R * K + C) * 2u; voffB[i] = (unsigned)(Rb * K + C) * 2u; }
    const size_t kstep = (size_t)(BK * 2);
    const size_t hstep = (size_t)HALF * K * 2;
    const size_t tstep = 2 * hstep;
    const unsigned ldsw = (unsigned)wid * 1024u;
    const int aoff = lds_byte(wr * 64 + fr, fq * 8), boff = lds_byte(wc * 32 + fr, fq * 8);
#define PG8_SA(b, h) (((b) * 2 + (h)) * HTB)
#define PG8_SB(b, h) ((4 + (b) * 2 + (h)) * HTB)
#define PG8_STAGE(bufoff, gbase, voff) do { _Pragma("unroll") for (int _i = 0; _i < 2; ++_i) \
        __builtin_amdgcn_global_load_lds((const unsigned*)((const char*)(gbase) + (voff)[_i]), (PG8_LAS unsigned*)(lds + (bufoff) + ldsw + _i * 8192), 16, 0, 0); } while (0)
#define PG8_LDA(dst, b, h) do { _Pragma("unroll") for (int m = 0; m < 4; ++m) _Pragma("unroll") for (int k = 0; k < 2; ++k) dst[m][k] = *(const PG8_LAS bf16x8*)(lds + PG8_SA(b, h) + aoff + m * 2048 + k * 1024); } while (0)
#define PG8_LDB(dst, b, h) do { _Pragma("unroll") for (int n = 0; n < 2; ++n) _Pragma("unroll") for (int k = 0; k < 2; ++k) dst[n][k] = *(const PG8_LAS bf16x8*)(lds + PG8_SB(b, h) + boff + n * 2048 + k * 1024); } while (0)
#define PG8_MMA(ai, bj, At, Bt) do { __builtin_amdgcn_s_setprio(1); _Pragma("unroll") for (int m = 0; m < 4; ++m) _Pragma("unroll") for (int n = 0; n < 2; ++n) _Pragma("unroll") for (int k = 0; k < 2; ++k) \
        acc[ai][bj][m][n] = __builtin_amdgcn_mfma_f32_16x16x32_bf16(Bt[n][k], At[m][k], acc[ai][bj][m][n], 0, 0, 0); __builtin_amdgcn_s_setprio(0); } while (0)
#define PG8_WAIT_V(n) asm volatile("s_waitcnt vmcnt(" #n ")" ::: "memory")
#define PG8_WAIT_L(n) asm volatile("s_waitcnt lgkmcnt(" #n ")" ::: "memory")
#define PG8_BAR __builtin_amdgcn_s_barrier()
#define PG8_SCHED __builtin_amdgcn_sched_barrier(0)
    Unit cur, nxt; int ui = 0;
    if (!S.next(0, cur)) return;
    f32x4 acc[2][2][4][2];
#pragma unroll
    for (int a = 0; a < 2; ++a)
#pragma unroll
        for (int b = 0; b < 2; ++b)
#pragma unroll
            for (int m = 0; m < 4; ++m)
#pragma unroll
                for (int n = 0; n < 2; ++n) acc[a][b][m][n] = (f32x4){0.f, 0.f, 0.f, 0.f};
    bf16x8 At[4][2], B0[2][2], B1[2][2];
    const char* cA = (const char*)g.A + (size_t)cur.pm * tstep; const char* cB = (const char*)g.Bt + (size_t)cur.pn * tstep;
    S.a_ready(cur);
    if constexpr (SP2) {
        PG8_STAGE(PG8_SB(0, 0), cB, voffB); PG8_STAGE(PG8_SB(0, 1), cB + hstep, voffB); PG8_STAGE(PG8_SA(0, 0), cA, voffA); PG8_STAGE(PG8_SA(0, 1), cA + hstep, voffA);
        if (wr == 1) PG8_BAR;
        PG8_WAIT_V(2); PG8_BAR;
        PG8_STAGE(PG8_SB(1, 0), cB + kstep, voffB); PG8_STAGE(PG8_SA(1, 0), cA + kstep, voffA); PG8_STAGE(PG8_SB(1, 1), cB + hstep + kstep, voffB);
        PG8_WAIT_V(6); PG8_BAR;
    } else {
        PG8_STAGE(PG8_SB(0, 0), cB, voffB); PG8_STAGE(PG8_SA(0, 0), cA, voffA); PG8_STAGE(PG8_SB(0, 1), cB + hstep, voffB); PG8_STAGE(PG8_SA(0, 1), cA + hstep, voffA);
        if (wr == 1) PG8_BAR;
        PG8_WAIT_V(4); PG8_BAR;
        PG8_STAGE(PG8_SB(1, 0), cB + kstep, voffB); PG8_STAGE(PG8_SA(1, 0), cA + kstep, voffA); PG8_STAGE(PG8_SB(1, 1), cB + hstep + kstep, voffB);
        PG8_WAIT_V(6); PG8_BAR;
    }
    for (;;) {
        const bool has_next = S.next(ui + 1, nxt);
        const char* nA = has_next ? (const char*)g.A + (size_t)nxt.pm * tstep : cA; const char* nB = has_next ? (const char*)g.Bt + (size_t)nxt.pn * tstep : cB;
        for (int t = 0; t < nt; t += 2) {
            const bool last = (t == nt - 2);
            const char* a1 = cA + (size_t)(t + 1) * kstep;
            const char* a2 = last ? nA : cA + (size_t)(t + 2) * kstep; const char* b2 = last ? nB : cB + (size_t)(t + 2) * kstep;
            const char* a3 = a2 + kstep; const char* b3 = b2 + kstep;
            if (last && has_next) S.a_ready(nxt);
            if constexpr (SP2) {
            PG8_LDB(B0, 0, 0); PG8_LDB(B1, 0, 1); PG8_SCHED; PG8_LDA(At, 0, 0); PG8_STAGE(PG8_SA(1, 1), a1 + hstep, voffA);
            PG8_WAIT_V(8); PG8_WAIT_L(0); PG8_BAR; PG8_MMA(0, 0, At, B0); PG8_MMA(0, 1, At, B1); PG8_BAR; PG8_SCHED;
            PG8_LDA(At, 0, 1); PG8_STAGE(PG8_SB(0, 0), b2, voffB); PG8_STAGE(PG8_SB(0, 1), b2 + hstep, voffB); PG8_STAGE(PG8_SA(0, 0), a2, voffA);
            PG8_WAIT_V(8); PG8_WAIT_L(0); PG8_BAR; PG8_MMA(1, 0, At, B0); PG8_MMA(1, 1, At, B1); PG8_BAR; PG8_SCHED;
            PG8_LDB(B0, 1, 0); PG8_LDB(B1, 1, 1); PG8_SCHED; PG8_LDA(At, 1, 0); PG8_STAGE(PG8_SA(0, 1), a2 + hstep, voffA);
            PG8_WAIT_V(8); PG8_WAIT_L(0); PG8_BAR; PG8_MMA(0, 0, At, B0); PG8_MMA(0, 1, At, B1); PG8_BAR; PG8_SCHED;
            PG8_LDA(At, 1, 1); PG8_STAGE(PG8_SB(1, 0), b3, voffB); PG8_STAGE(PG8_SB(1, 1), b3 + hstep, voffB); PG8_STAGE(PG8_SA(1, 0), a3, voffA);
            PG8_WAIT_V(8); PG8_WAIT_L(0); PG8_BAR; PG8_MMA(1, 0, At, B0); PG8_MMA(1, 1, At, B1); PG8_BAR; PG8_SCHED;
            } else {
            PG8_LDB(B0, 0, 0); PG8_SCHED; PG8_LDA(At, 0, 0); PG8_STAGE(PG8_SA(1, 1), a1 + hstep, voffA);
            PG8_WAIT_L(8); PG8_BAR; PG8_WAIT_L(0); PG8_MMA(0, 0, At, B0); PG8_BAR; PG8_SCHED;
            PG8_LDB(B1, 0, 1); PG8_STAGE(PG8_SB(0, 0), b2, voffB);
            PG8_BAR; PG8_WAIT_L(0); PG8_MMA(0, 1, At, B1); PG8_BAR;
            PG8_LDA(At, 0, 1); PG8_STAGE(PG8_SA(0, 0), a2, voffA);
            PG8_BAR; PG8_WAIT_L(0); PG8_MMA(1, 0, At, B0); PG8_BAR; PG8_SCHED;
            PG8_STAGE(PG8_SB(0, 1), b2 + hstep, voffB);
            PG8_WAIT_V(6); PG8_BAR; PG8_MMA(1, 1, At, B1); PG8_BAR;
            PG8_LDB(B0, 1, 0); PG8_SCHED; PG8_LDA(At, 1, 0); PG8_STAGE(PG8_SA(0, 1), a2 + hstep, voffA);
            PG8_WAIT_L(8); PG8_BAR; PG8_WAIT_L(0); PG8_MMA(0, 0, At, B0); PG8_BAR; PG8_SCHED;
            PG8_LDB(B1, 1, 1); PG8_STAGE(PG8_SB(1, 0), b3, voffB);
            PG8_BAR; PG8_WAIT_L(0); PG8_MMA(0, 1, At, B1); PG8_BAR;
            PG8_LDA(At, 1, 1); PG8_STAGE(PG8_SA(1, 0), a3, voffA);
            PG8_BAR; PG8_WAIT_L(0); PG8_MMA(1, 0, At, B0); PG8_BAR; PG8_SCHED;
            PG8_STAGE(PG8_SB(1, 1), b3 + hstep, voffB);
            PG8_WAIT_V(6); PG8_BAR; PG8_MMA(1, 1, At, B1); PG8_BAR;
            }
        }
        if constexpr (ALIGN_EPI) { if (wr == 0) PG8_BAR; }
        if constexpr (!Epi::AFTER_DRAIN) { E(acc, cur, wr, wc, fr, fq); S.done(cur); }
        if (!has_next) break;
#pragma unroll
        for (int a = 0; a < 2; ++a)
#pragma unroll
            for (int b = 0; b < 2; ++b)
#pragma unroll
                for (int m = 0; m < 4; ++m)
#pragma unroll
                    for (int n = 0; n < 2; ++n) acc[a][b][m][n] = (f32x4){0.f, 0.f, 0.f, 0.f};
        cur = nxt; cA = nA; cB = nB; ++ui;
        if constexpr (ALIGN_EPI) { if (wr == 1) PG8_BAR; }
    }
    PG8_WAIT_V(0);
    if constexpr (!ALIGN_EPI) { if (wr == 0) PG8_BAR; }
    PG8_BAR;
    if constexpr (Epi::AFTER_DRAIN) { E.fused(acc, cur, wr, wc, fr, fq, lds, wid, lane); S.done(cur); }
#undef PG8_SA
#undef PG8_SB
#undef PG8_STAGE
#undef PG8_LDA
#undef PG8_LDB
#undef PG8_MMA
#undef PG8_WAIT_V
#undef PG8_WAIT_L
#undef PG8_BAR
#undef PG8_SCHED
}
}

namespace cg = cooperative_groups;
#define GAS __attribute__((address_space(1)))
#define LAS __attribute__((address_space(3)))
typedef unsigned short bf16;
typedef unsigned v4u __attribute__((ext_vector_type(4)));
typedef unsigned v2u __attribute__((ext_vector_type(2)));
typedef float f32x4 __attribute__((ext_vector_type(4)));
typedef float f32x16 __attribute__((ext_vector_type(16)));
typedef short bf16x8 __attribute__((ext_vector_type(8)));
typedef short s16x4 __attribute__((ext_vector_type(4)));
typedef float f32x2_t __attribute__((ext_vector_type(2)));
typedef __bf16 bf16x2_t __attribute__((ext_vector_type(2)));
#define LDS_WAIT() asm volatile("s_waitcnt lgkmcnt(0)" ::: "memory")

#define RLX_AGENT __ATOMIC_RELAXED, __HIP_MEMORY_SCOPE_AGENT
#define XB_TMO      128
#define XB_XCNT(j)  (256  + 64 * (j))
#define XB_XSUB(j)  (1280 + 64 * (j))
#define XB_XGEN(j)  (2304 + 64 * (j))
#define XB_TOP      3328
#define XB_TOPGEN   3392
#define XCD_BAR_WORDS 3456
#define XB_SPIN_CAP (1u << 18)

__device__ __forceinline__ unsigned xb_ld(unsigned* p)              { return __hip_atomic_load(p, __ATOMIC_RELAXED, __HIP_MEMORY_SCOPE_AGENT); }
__device__ __forceinline__ unsigned xb_add(unsigned* p, unsigned v) { return __hip_atomic_fetch_add(p, v, __ATOMIC_RELAXED, __HIP_MEMORY_SCOPE_AGENT); }
__device__ __forceinline__ unsigned xb_xcc_id() { return (unsigned)__builtin_amdgcn_s_getreg((3 << 11) | 20) & 0xFu; }
#define XB_SPIN(cond, bar) do { unsigned _sp = 0; while (cond) { __builtin_amdgcn_s_sleep(1); \
    if ((++_sp & 255u) == 0u) { if (xb_ld(&(bar)[XB_TMO])) break; if (_sp > XB_SPIN_CAP) { atomicAdd(&(bar)[XB_TMO], 1u); break; } } } } while (0)

struct XcdBarrier {
    unsigned* bar; unsigned x;
    volatile LAS unsigned* st;
};

__device__ __forceinline__ XcdBarrier xcd_barrier_post(unsigned* bar, volatile LAS unsigned* st) {
    XcdBarrier b; b.bar = bar; b.x = xb_xcc_id(); b.st = st;
    if (threadIdx.x == 0) (void)xb_add(&bar[XB_XCNT(b.x)], 1u);
    return b;
}
__device__ __forceinline__ void xcd_barrier_complete(unsigned* bar, unsigned x, unsigned& nloc, unsigned& nx) {
    const unsigned G = gridDim.x * gridDim.y * gridDim.z;
    unsigned sum, cnt, mine, sp = 0u;
    for (;;) {
        sum = 0u; cnt = 0u; mine = 0u;
#pragma unroll
        for (unsigned j = 0; j < 16; ++j) { const unsigned c = xb_ld(&bar[XB_XCNT(j)]); sum += c; cnt += (c > 0u) ? 1u : 0u; mine = (j == x) ? c : mine; }
        if (sum == G) break;
        __builtin_amdgcn_s_sleep(1);
        if ((++sp & 255u) == 0u) { if (xb_ld(&bar[XB_TMO])) break; if (sp > XB_SPIN_CAP) { atomicAdd(&bar[XB_TMO], 1u); break; } }
    }
    nloc = mine > 0u ? mine : 1u; nx = cnt > 0u ? cnt : 1u;
}

__device__ __forceinline__ void xcd_barrier(const XcdBarrier& b) {
    asm volatile("s_waitcnt vmcnt(0)" ::: "memory");
    __syncthreads();
    if (threadIdx.x == 0) {
        unsigned* bar = b.bar;
        __builtin_amdgcn_s_waitcnt(0);
        unsigned nloc = b.st[0], nx = b.st[1];
        if (nloc == 0u) { xcd_barrier_complete(bar, b.x, nloc, nx); b.st[0] = nloc; b.st[1] = nx; }
        const unsigned old = xb_add(&bar[XB_XSUB(b.x)], 1u);
        const unsigned gen = old / nloc;
        if (old + 1u == (gen + 1u) * nloc) {
            __builtin_amdgcn_fence(__ATOMIC_RELEASE, "agent");
            asm volatile("s_waitcnt vmcnt(0)" ::: "memory");
            const unsigned og = xb_add(&bar[XB_TOP], 1u);
            const unsigned tg = og / nx;
            if (og + 1u == (tg + 1u) * nx) xb_add(&bar[XB_TOPGEN], 1u);
            else XB_SPIN(xb_ld(&bar[XB_TOPGEN]) == tg, bar);
            __builtin_amdgcn_fence(__ATOMIC_ACQUIRE, "agent");
            xb_add(&bar[XB_XGEN(b.x)], 1u);
            asm volatile("s_waitcnt vmcnt(0)" ::: "memory");
        } else {
            XB_SPIN(xb_ld(&bar[XB_XGEN(b.x)]) == gen, bar);
            __builtin_amdgcn_fence(__ATOMIC_ACQUIRE, "agent");
            asm volatile("s_waitcnt vmcnt(0)" ::: "memory");
        }
    }
    __syncthreads();
}

constexpr int NWAVES = 8;
#ifndef REP_P0
#define REP_P0 1
#endif
#ifndef REP_P1
#define REP_P1 1
#endif
#ifndef REP_P2
#define REP_P2 1
#endif
#ifndef REP_P3
#define REP_P3 1
#endif
#ifndef REP_P4
#define REP_P4 1
#endif
#ifndef REP_PP
#define REP_PP 1
#endif
#ifndef REP_SYNC
#define REP_SYNC 1
#endif
#define GRID_SYNC() do { for (int rs_ = 0; rs_ < REP_SYNC; ++rs_) xcd_barrier(bar); } while (0)
constexpr int BATCH = 4, SEQ = 4096, D = 1024, M = BATCH * SEQ, INC = 3072, FF = 4096, PLE = 256, WCONV = 512, NH = 8, HD = 64;
constexpr int QOFF = 1536, KOFF = 2048, VOFF = 2560;
constexpr float EPS = 1e-6f;
constexpr size_t MiB = 1u << 20;
constexpr size_t WS_CTL = 0, CTL_ZERO_BYTES = 16384;
constexpr size_t WS_SS1 = 1 * MiB, WS_SS2 = 2 * MiB;
constexpr size_t WS_WIN = 4 * MiB, WS_WOUT = 10 * MiB, WS_WUP = 12 * MiB, WS_WDN = 20 * MiB, WS_WG = 28 * MiB, WS_WPP = 30 * MiB;
constexpr size_t WS_PB = 31 * MiB;
constexpr size_t WS_XN = 40 * MiB;
constexpr size_t WS_HB = 72 * MiB;
constexpr size_t WS_PROJ = 104 * MiB;
constexpr size_t WS_END = 232 * MiB;

__device__ __forceinline__ unsigned f2bf(float f) { unsigned u = __builtin_bit_cast(unsigned, f); return (u + 0x7fffu + ((u >> 16) & 1u)) >> 16; }
__device__ __forceinline__ unsigned pk2(float lo, float hi) { f32x2_t v = {lo, hi}; bf16x2_t b = __builtin_convertvector(v, bf16x2_t); return __builtin_bit_cast(unsigned, b); }
__device__ __forceinline__ float bflo(unsigned w) { return __uint_as_float(w << 16); }
__device__ __forceinline__ float bfhi(unsigned w) { return __uint_as_float(w & 0xffff0000u); }
__device__ __forceinline__ float wave_sum(float v) {
#pragma unroll
    for (int o = 1; o < 64; o <<= 1) v += __shfl_xor(v, o);
    return v;
}
__device__ __forceinline__ void p0_transpose_item(const float* W, const float* g, int K, int N, bf16* WT, LAS float* scr, int item, int lane) {
    const int nblk = N / 32, kb = item / nblk, nb = item % nblk, k0 = 64 * kb, n0 = 32 * nb;
#pragma unroll 8
    for (int i = 0; i < 32; ++i) { const int kk = 2 * i + (lane >> 5); const float gv = g ? g[k0 + kk] : 1.0f; scr[kk * 33 + (lane & 31)] = W[(size_t)(k0 + kk) * N + n0 + (lane & 31)] * gv; }
    LDS_WAIT(); asm volatile("" ::: "memory");
    const int c = lane & 7;
#pragma unroll
    for (int j = 0; j < 4; ++j) { const int n = (lane >> 3) + 8 * j; const LAS float* s = scr + (8 * c) * 33 + n;
        v4u o; o.x = pk2(s[0 * 33], s[1 * 33]); o.y = pk2(s[2 * 33], s[3 * 33]); o.z = pk2(s[4 * 33], s[5 * 33]); o.w = pk2(s[6 * 33], s[7 * 33]);
        *(GAS v4u*)(WT + (size_t)(n0 + n) * K + k0 + 8 * c) = o; }
    LDS_WAIT(); asm volatile("" ::: "memory");
}
__device__ __forceinline__ void rms_row_to_bf16(const float* xrow, const float* g, bf16* orow, int lane) {
    const GAS f32x4* xr = (const GAS f32x4*)xrow + lane; const GAS f32x4* gr = (const GAS f32x4*)g + lane;
    f32x4 v[4]; float s = 0.f;
#pragma unroll
    for (int j = 0; j < 4; ++j) { v[j] = xr[64 * j]; s += (v[j].x * v[j].x + v[j].y * v[j].y) + (v[j].z * v[j].z + v[j].w * v[j].w); }
    const float rs = 1.f / sqrtf(wave_sum(s) * (1.f / D) + EPS);
    GAS v2u* o8 = (GAS v2u*)orow + lane;
#pragma unroll
    for (int j = 0; j < 4; ++j) { const f32x4 gg = gr[64 * j]; v2u w; w.x = pk2(v[j].x * rs * gg.x, v[j].y * rs * gg.y); w.y = pk2(v[j].z * rs * gg.z, v[j].w * rs * gg.w); o8[64 * j] = w; }
}
__device__ __forceinline__ void rms_row_final(const bf16* hrow, const float* g, float* orow, int lane) {
    float v[16];
    { const v4u a = *(const GAS v4u*)(hrow + 8 * lane), b = *(const GAS v4u*)(hrow + 512 + 8 * lane);
      v[0] = bflo(a.x); v[1] = bfhi(a.x); v[2] = bflo(a.y); v[3] = bfhi(a.y); v[4] = bflo(a.z); v[5] = bfhi(a.z); v[6] = bflo(a.w); v[7] = bfhi(a.w);
      v[8] = bflo(b.x); v[9] = bfhi(b.x); v[10] = bflo(b.y); v[11] = bfhi(b.y); v[12] = bflo(b.z); v[13] = bfhi(b.z); v[14] = bflo(b.w); v[15] = bfhi(b.w); }
    float s = 0.f;
#pragma unroll
    for (int j = 0; j < 16; ++j) s += v[j] * v[j];
    const float rs = 1.f / sqrtf(wave_sum(s) * (1.f / D) + EPS);
#pragma unroll
    for (int j = 0; j < 4; ++j) { const int c = (j >> 1) * 512 + 8 * lane + (j & 1) * 4; const f32x4 gg = *(const GAS f32x4*)(g + c);
        f32x4 o; o.x = v[4 * j] * rs * gg.x; o.y = v[4 * j + 1] * rs * gg.y; o.z = v[4 * j + 2] * rs * gg.z; o.w = v[4 * j + 3] * rs * gg.w; *(GAS f32x4*)(orow + c) = o; }
}

__device__ __forceinline__ void unpack8(const v4u w, float (&f)[8]) { f[0] = bflo(w.x); f[1] = bfhi(w.x); f[2] = bflo(w.y); f[3] = bfhi(w.y); f[4] = bflo(w.z); f[5] = bfhi(w.z); f[6] = bflo(w.w); f[7] = bfhi(w.w); }
__device__ __forceinline__ void conv_chunk(const bf16* PROJ, bf16* MIX, const float* cw, const float* gco, int row0, int lane) {
    const int c0 = lane * 8;
    float w0[8], w1[8], w2[8], gg[8];
#pragma unroll
    for (int j = 0; j < 8; ++j) { w0[j] = cw[c0 + j]; w1[j] = cw[WCONV + c0 + j]; w2[j] = cw[2 * WCONV + c0 + j]; gg[j] = gco[c0 + j]; }
    float vm2[8], vm1[8];
#pragma unroll
    for (int j = 0; j < 8; ++j) { vm2[j] = 0.f; vm1[j] = 0.f; }
    if ((row0 & (SEQ - 1)) != 0) {
        float a[8], b[8];
        const bf16* p2 = PROJ + (size_t)(row0 - 2) * INC + c0; const bf16* p1 = PROJ + (size_t)(row0 - 1) * INC + c0;
        unpack8(*(const GAS v4u*)(p2 + 512), a); unpack8(*(const GAS v4u*)(p2 + 1024), b);
#pragma unroll
        for (int j = 0; j < 8; ++j) vm2[j] = a[j] * b[j];
        unpack8(*(const GAS v4u*)(p1 + 512), a); unpack8(*(const GAS v4u*)(p1 + 1024), b);
#pragma unroll
        for (int j = 0; j < 8; ++j) vm1[j] = a[j] * b[j];
    }
#pragma unroll 2
    for (int i = 0; i < 8; ++i) {
        const bf16* pr = PROJ + (size_t)(row0 + i) * INC + c0;
        float cb[8], cc[8], cu[8], y[8];
        unpack8(*(const GAS v4u*)(pr), cb); unpack8(*(const GAS v4u*)(pr + 512), cc); unpack8(*(const GAS v4u*)(pr + 1024), cu);
        float ss = 0.f;
#pragma unroll
        for (int j = 0; j < 8; ++j) { const float v = cc[j] * cu[j]; y[j] = cb[j] * (w0[j] * vm2[j] + w1[j] * vm1[j] + w2[j] * v); ss += y[j] * y[j]; vm2[j] = vm1[j]; vm1[j] = v; }
        ss += __shfl_xor(ss, 1); ss += __shfl_xor(ss, 2); ss += __shfl_xor(ss, 4);
        const float rs = 1.f / sqrtf(ss * (1.f / HD) + EPS);
        v4u o; o.x = pk2(y[0] * rs * gg[0], y[1] * rs * gg[1]); o.y = pk2(y[2] * rs * gg[2], y[3] * rs * gg[3]); o.z = pk2(y[4] * rs * gg[4], y[5] * rs * gg[5]); o.w = pk2(y[6] * rs * gg[6], y[7] * rs * gg[7]);
        *(GAS v4u*)(MIX + (size_t)(row0 + i) * D + c0) = o;
    }
}

__device__ __forceinline__ int crow(int r, int hi) { return (r & 3) + 8 * (r >> 2) + 4 * hi; }
constexpr int VPITCH = 144;
__device__ __forceinline__ void sb_unit(const bf16* PROJ, bf16* MIX, const float* gattn, int b, int h, int qt, LAS unsigned char* vl, int lane) {
    const int r = lane & 31, hh = lane >> 5;
    const size_t rowbase = (size_t)b * SEQ;
    const bf16* qp = PROJ + (rowbase + qt * 32 + r) * INC + QOFF + h * HD + 8 * hh;
    bf16x8 qf[4];
#pragma unroll
    for (int d0 = 0; d0 < 4; ++d0) qf[d0] = *(const GAS bf16x8*)(qp + d0 * 16);
    f32x16 o0, o1;
#pragma unroll
    for (int i = 0; i < 16; ++i) { o0[i] = 0.f; o1[i] = 0.f; }
    float R = 0.f;
    const float SC = 0.125f * 1.4426950408889634f;
    const bf16* kbase = PROJ + (rowbase + r) * INC + KOFF + h * HD + 8 * hh;
    const bf16* vbase = PROJ + (rowbase + (lane >> 3)) * INC + VOFF + h * HD + (lane & 7) * 8;
    bf16x8 kf[4]; v4u vv[4];
#define SB_LOADT(t) do { const bf16* kp_ = kbase + (size_t)(t) * 32 * INC; const bf16* vp_ = vbase + (size_t)(t) * 32 * INC; \
        _Pragma("unroll") for (int d0 = 0; d0 < 4; ++d0) kf[d0] = *(const GAS bf16x8*)(kp_ + d0 * 16); \
        _Pragma("unroll") for (int i = 0; i < 4; ++i) vv[i] = *(const GAS v4u*)(vp_ + (size_t)(8 * i) * INC); } while (0)
    SB_LOADT(qt);
    const int i16 = lane & 15, q4 = i16 >> 2, p4 = i16 & 3, blk = (lane >> 4) & 1;
    LAS unsigned char* vrd = vl + (4 * hh + q4) * VPITCH + blk * 32 + p4 * 8;
    LAS unsigned char* vwr = vl + (lane >> 3) * VPITCH + (lane & 7) * 16;
    for (int kt = qt; kt >= 0; --kt) {
        bf16x8 kc[4]; v4u vc[4];
#pragma unroll
        for (int i = 0; i < 4; ++i) { kc[i] = kf[i]; vc[i] = vv[i]; }
        if (kt > 0) SB_LOADT(kt - 1);
#pragma unroll
        for (int i = 0; i < 4; ++i) *(LAS v4u*)(vwr + 8 * i * VPITCH) = vc[i];
        f32x16 s;
#pragma unroll
        for (int i = 0; i < 16; ++i) s[i] = 0.f;
#pragma unroll
        for (int d0 = 0; d0 < 4; ++d0) s = __builtin_amdgcn_mfma_f32_32x32x16_bf16(kc[d0], qf[d0], s, 0, 0, 0);
        float z2[16], lk[16], p[16];
        const bool diag = (kt == qt);
#pragma unroll
        for (int i = 0; i < 16; ++i) { z2[i] = s[i] * SC; const float e = __builtin_amdgcn_exp2f(-fabsf(z2[i])); const float l = __builtin_amdgcn_logf(1.0f + e); lk[i] = -(fmaxf(z2[i], 0.f) + l); }
        if (diag) {
#pragma unroll
            for (int i = 0; i < 16; ++i) if (crow(i, hh) >= r) lk[i] = 0.f;
        }
        float g[4], og[4], tot[4], T[4];
#pragma unroll
        for (int a = 0; a < 4; ++a) { g[a] = (lk[4 * a] + lk[4 * a + 1]) + (lk[4 * a + 2] + lk[4 * a + 3]); og[a] = __shfl_xor(g[a], 32); tot[a] = g[a] + og[a]; }
        T[3] = R; T[2] = T[3] + tot[3]; T[1] = T[2] + tot[2]; T[0] = T[1] + tot[1];
        const float Rn = T[0] + tot[0];
        if (hh == 0) {
#pragma unroll
            for (int a = 0; a < 4; ++a) T[a] += og[a];
        }
#pragma unroll
        for (int a = 0; a < 4; ++a) { const float c3 = T[a], c2 = c3 + lk[4 * a + 3], c1 = c2 + lk[4 * a + 2], c0 = c1 + lk[4 * a + 1];
            p[4 * a + 3] = __builtin_amdgcn_exp2f(z2[4 * a + 3] + lk[4 * a + 3] + c3); p[4 * a + 2] = __builtin_amdgcn_exp2f(z2[4 * a + 2] + lk[4 * a + 2] + c2);
            p[4 * a + 1] = __builtin_amdgcn_exp2f(z2[4 * a + 1] + lk[4 * a + 1] + c1); p[4 * a] = __builtin_amdgcn_exp2f(z2[4 * a] + lk[4 * a] + c0); }
        if (diag) {
#pragma unroll
            for (int i = 0; i < 16; ++i) if (crow(i, hh) >= r) p[i] = 0.f;
        }
        R = Rn;
        v4u pw0, pw1;
        pw0.x = pk2(p[0], p[1]); pw0.y = pk2(p[2], p[3]); pw0.z = pk2(p[4], p[5]); pw0.w = pk2(p[6], p[7]);
        pw1.x = pk2(p[8], p[9]); pw1.y = pk2(p[10], p[11]); pw1.z = pk2(p[12], p[13]); pw1.w = pk2(p[14], p[15]);
        const bf16x8 pf0 = __builtin_bit_cast(bf16x8, pw0), pf1 = __builtin_bit_cast(bf16x8, pw1);
        asm volatile("" ::: "memory");
#define SB_VTR(off) __builtin_bit_cast(s16x4, __builtin_amdgcn_ds_read_tr16_b64_v4i16((LAS s16x4*)(vrd + (off))))
#pragma unroll
        for (int sk = 0; sk < 2; ++sk) {
            const s16x4 l0 = SB_VTR(16 * sk * VPITCH), h0 = SB_VTR((16 * sk + 8) * VPITCH), l1 = SB_VTR(16 * sk * VPITCH + 64), h1 = SB_VTR((16 * sk + 8) * VPITCH + 64);
            const bf16x8 v0 = __builtin_shufflevector(l0, h0, 0, 1, 2, 3, 4, 5, 6, 7), v1 = __builtin_shufflevector(l1, h1, 0, 1, 2, 3, 4, 5, 6, 7);
            o0 = __builtin_amdgcn_mfma_f32_32x32x16_bf16(v0, sk ? pf1 : pf0, o0, 0, 0, 0);
            o1 = __builtin_amdgcn_mfma_f32_32x32x16_bf16(v1, sk ? pf1 : pf0, o1, 0, 0, 0);
        }
        asm volatile("" ::: "memory");
        if (__all(R < -150.0f)) break;
    }
#undef SB_VTR
#undef SB_LOADT
    float ss = 0.f;
#pragma unroll
    for (int i = 0; i < 16; ++i) ss += o0[i] * o0[i] + o1[i] * o1[i];
    ss += __shfl_xor(ss, 32);
    const float rs = 1.f / sqrtf(ss * (1.f / HD) + EPS);
    bf16* op = MIX + (rowbase + qt * 32 + r) * D + WCONV + h * HD + 4 * hh;
    const float* gp = gattn + h * HD + 4 * hh;
#pragma unroll
    for (int a = 0; a < 4; ++a) {
        const f32x4 g0 = *(const GAS f32x4*)(gp + 8 * a), g1 = *(const GAS f32x4*)(gp + 32 + 8 * a);
        v2u w0, w1;
        w0.x = pk2(o0[4 * a] * rs * g0.x, o0[4 * a + 1] * rs * g0.y); w0.y = pk2(o0[4 * a + 2] * rs * g0.z, o0[4 * a + 3] * rs * g0.w);
        w1.x = pk2(o1[4 * a] * rs * g1.x, o1[4 * a + 1] * rs * g1.y); w1.y = pk2(o1[4 * a + 2] * rs * g1.z, o1[4 * a + 3] * rs * g1.w);
        *(GAS v2u*)(op + 8 * a) = w0; *(GAS v2u*)(op + 32 + 8 * a) = w1;
    }
}

constexpr int LDS_BYTES = 147456;
struct Args { const float* in[15]; float* out; unsigned char* ws; };
__global__ void __launch_bounds__(NWAVES * 64, 2) hymba_fwd(Args args) {
    extern __shared__ __attribute__((aligned(16))) unsigned char lds_raw[];
    cg::grid_group grid = cg::this_grid();
    LAS unsigned char* lds = (LAS unsigned char*)lds_raw;
    const int tid = threadIdx.x, lane = tid & 63, wave = __builtin_amdgcn_readfirstlane(tid >> 6);
    const int G = gridDim.x; const int bx = blockIdx.x; const int vcu = (G % 8 == 0) ? (bx % 8) * (G / 8) + bx / 8 : bx;
    const int gw = vcu * NWAVES + wave, NGW = G * NWAVES;
    const float* x = args.in[0]; const float* pin = args.in[1]; const float* g_mix = args.in[2]; const float* w_in = args.in[3]; const float* conv_w = args.in[4];
    const float* g_conv = args.in[5]; const float* g_attn = args.in[6]; const float* w_out = args.in[7]; const float* g_mlp = args.in[8]; const float* w_up = args.in[9];
    const float* w_down = args.in[10]; const float* g_ple = args.in[11]; const float* w_gate = args.in[12]; const float* w_pp = args.in[13]; const float* g_final = args.in[14];
    float* out = args.out; unsigned char* ws = args.ws;
    volatile LAS unsigned* bst = (volatile LAS unsigned*)(lds + 131072);
    if (tid == 0) { bst[0] = 0u; bst[1] = 0u; }
    __syncthreads();
    const XcdBarrier bar = xcd_barrier_post((unsigned*)(ws + WS_CTL), bst);
    if (G > 65536) grid.sync();
    float* SS1 = (float*)(ws + WS_SS1); float* SS2 = (float*)(ws + WS_SS2);
    bf16* WIN = (bf16*)(ws + WS_WIN); bf16* WOUT = (bf16*)(ws + WS_WOUT); bf16* WUP = (bf16*)(ws + WS_WUP); bf16* WDN = (bf16*)(ws + WS_WDN); bf16* WG = (bf16*)(ws + WS_WG); bf16* WPP = (bf16*)(ws + WS_WPP);
    bf16* PB = (bf16*)(ws + WS_PB); bf16* XN = (bf16*)(ws + WS_XN); bf16* HB = (bf16*)(ws + WS_HB); bf16* PROJ = (bf16*)(ws + WS_PROJ);
    bf16* MIX = XN; bf16* PP = XN; bf16* U = PROJ; bf16* H3B = PROJ;

    _Pragma("unroll") for (int rep_ = 0; rep_ < REP_P0; ++rep_) {
        LAS float* scr = (LAS float*)(lds + wave * 16384);
        constexpr int I_IN = (D / 64) * (INC / 32), I_OUT = (D / 64) * (D / 32), I_UP = (D / 64) * (FF / 32), I_DN = (FF / 64) * (D / 32), I_G = I_OUT, I_PP = (PLE / 64) * (D / 32);
        constexpr int NITEMS = I_IN + I_OUT + I_UP + I_DN + I_G + I_PP;
        for (int it = gw; it < NITEMS; it += NGW) {
            int r = it;
            if (r < I_IN) { p0_transpose_item(w_in, nullptr, D, INC, WIN, scr, r, lane); continue; } r -= I_IN;
            if (r < I_OUT) { p0_transpose_item(w_out, nullptr, D, D, WOUT, scr, r, lane); continue; } r -= I_OUT;
            if (r < I_UP) { p0_transpose_item(w_up, g_mlp, D, FF, WUP, scr, r, lane); continue; } r -= I_UP;
            if (r < I_DN) { p0_transpose_item(w_down, nullptr, FF, D, WDN, scr, r, lane); continue; } r -= I_DN;
            if (r < I_G) { p0_transpose_item(w_gate, g_ple, D, D, WG, scr, r, lane); continue; } r -= I_G;
            p0_transpose_item(w_pp, nullptr, PLE, D, WPP, scr, r, lane);
        }
        for (int m = gw; m < M; m += NGW) rms_row_to_bf16(x + (size_t)m * D, g_mix, XN + (size_t)m * D, lane);
        for (int i = gw * 64 + lane; i < M * PLE / 8; i += NGW * 64) {
            const f32x4 a = *(const GAS f32x4*)(pin + (size_t)i * 8), b = *(const GAS f32x4*)(pin + (size_t)i * 8 + 4);
            v4u o; o.x = pk2(a.x, a.y); o.y = pk2(a.z, a.w); o.z = pk2(b.x, b.y); o.w = pk2(b.z, b.w);
            *(GAS v4u*)(PB + (size_t)i * 8) = o;
        }
    }
    GRID_SYNC();
    _Pragma("unroll") for (int rep_ = 0; rep_ < REP_P1; ++rep_) {
        pg8::Gemm g{XN, WIN, M, INC, D}; pg8::StaticOrder S; S.init(M, INC, G, bx);
        pg8::EpiBf16 E{PROJ, INC};
        pg8::gemm_phase<pg8::EpiBf16, pg8::StaticOrder, true, true>(lds, g, S, E);
    }
    GRID_SYNC();
    _Pragma("unroll") for (int rep_ = 0; rep_ < REP_P2; ++rep_) {
        for (int c = gw; c < M / 8; c += NGW) conv_chunk(PROJ, MIX, conv_w, g_conv, c * 8, lane);
        LAS unsigned char* vl = lds + wave * 8192;
        for (int u = gw; u < BATCH * NH * (SEQ / 32); u += NGW) { const int bh = u / (SEQ / 32), qt = u % (SEQ / 32); sb_unit(PROJ, MIX, g_attn, bh / NH, bh % NH, qt, vl, lane); }
    }
    GRID_SYNC();
    _Pragma("unroll") for (int rep_ = 0; rep_ < REP_P3; ++rep_) {
        pg8::Gemm g{MIX, WOUT, M, D, D}; pg8::StaticOrder S; S.init(M, D, G, bx);
        pg8::EpiRes<true, false> E{x, nullptr, HB, D, nullptr, SS1, M, EPS};
        pg8::gemm_phase<pg8::EpiRes<true, false>, pg8::StaticOrder, true, true>(lds, g, S, E);
    }
    GRID_SYNC();
    _Pragma("unroll") for (int rep_ = 0; rep_ < REP_P4; ++rep_) {
        pg8::Gemm g{HB, WUP, M, FF, D}; pg8::StaticOrder S; S.init(M, FF, G, bx);
        pg8::EpiUp E{U, FF};
        pg8::gemm_phase<pg8::EpiUp, pg8::StaticOrder, true, true>(lds, g, S, E);
    }
    GRID_SYNC();
    {
        pg8::Gemm g{U, WDN, M, D, FF}; pg8::StaticOrder S; S.init(M, D, G, bx);
        pg8::EpiRes<false, true> E{nullptr, HB, HB, D, SS1, SS2, M, EPS};
        pg8::gemm_phase<pg8::EpiRes<false, true>, pg8::StaticOrder, true, true>(lds, g, S, E);
    }
    _Pragma("unroll") for (int rep_ = 0; rep_ < REP_PP; ++rep_) {
        pg8::Gemm g{PB, WPP, M, D, PLE}; pg8::StaticOrder S; S.init(M, D, G, bx);
        pg8::EpiBf16 E{PP, D};
        pg8::gemm_phase<pg8::EpiBf16, pg8::StaticOrder, true, true>(lds, g, S, E);
    }
    GRID_SYNC();
    {
        pg8::Gemm g{HB, WG, M, D, D}; pg8::StaticOrder S; S.init(M, D, G, bx);
        pg8::EpiGate E{HB, H3B, PP, D, SS2, M, EPS};
        pg8::gemm_phase<pg8::EpiGate, pg8::StaticOrder, true, true>(lds, g, S, E);
    }
    GRID_SYNC();
    for (int m = gw; m < M; m += NGW) rms_row_final(H3B + (size_t)m * D, g_final, out + (size_t)m * D, lane);
}

extern "C" void kernel_launch(void* const* d_in, const int* in_sizes, int n_in, void* d_out, int out_size, void* d_ws, size_t ws_size, hipStream_t stream) {
    static int grid = 0;
    if (grid == 0) {
        if (n_in != 15 || in_sizes[0] != M * D || out_size != M * D || ws_size < WS_END) { fprintf(stderr, "kernel_launch: unexpected shapes (n_in %d, in0 %d, out %d, ws %zu); nothing launched\n", n_in, n_in > 0 ? in_sizes[0] : -1, out_size, ws_size); grid = -1; return; }
        int dev = 0, cus = 0, per_cu = 0;
        if (hipGetDevice(&dev) != hipSuccess || hipDeviceGetAttribute(&cus, hipDeviceAttributeMultiprocessorCount, dev) != hipSuccess) { fprintf(stderr, "kernel_launch: device query failed\n"); grid = -1; return; }
        if (hipFuncSetAttribute((const void*)hymba_fwd, hipFuncAttributeMaxDynamicSharedMemorySize, LDS_BYTES) != hipSuccess) { fprintf(stderr, "kernel_launch: hipFuncSetAttribute failed\n"); grid = -1; return; }
        if (hipOccupancyMaxActiveBlocksPerMultiprocessor(&per_cu, (const void*)hymba_fwd, NWAVES * 64, LDS_BYTES) != hipSuccess || per_cu < 1) { fprintf(stderr, "kernel_launch: occupancy query gave %d\n", per_cu); per_cu = 1; }
        (void)hipGetLastError();
        grid = cus * per_cu;
    }
    if (grid < 0) return;
    if (hipMemsetAsync((char*)d_ws + WS_CTL, 0, CTL_ZERO_BYTES, stream) != hipSuccess) { fprintf(stderr, "kernel_launch: memset of the barrier words failed\n"); return; }
    Args a{};
    for (int i = 0; i < 15; ++i) a.in[i] = (const float*)d_in[i];
    a.out = (float*)d_out; a.ws = (unsigned char*)d_ws;
    void* kargs[] = {&a};
    const hipError_t e = hipLaunchCooperativeKernel((const void*)hymba_fwd, dim3(grid), dim3(NWAVES * 64), kargs, LDS_BYTES, stream);
    if (e != hipSuccess) fprintf(stderr, "kernel_launch: cooperative launch failed: %s (grid %d)\n", hipGetErrorString(e), grid);
}
```
